# Optimizing an MI355X kernel written in HIP

```python
import math
import jax
import jax.numpy as jnp
from jax import lax
import numpy as np

D_MODEL = 2048
BATCH = 1
SEQ = 8192
DEPTH = 1

N_META = 16
CHUNK = 128
PREFIX = CHUNK
PAD = PREFIX - N_META
Q_BLOCK = 128
GRID_W = 64
ROPE_THETA = 10000.0
NORM_EPS = 1e-6

MIX_WIDTH = D_MODEL
RET_WIDTH = MIX_WIDTH // 2
ATTN_WIDTH = MIX_WIDTH - RET_WIDTH
RET_V_DIM = 128
RET_HEADS = RET_WIDTH // RET_V_DIM
RET_QK_DIM = RET_V_DIM // 2
ATTN_HEAD_DIM = 128
ATTN_HEADS = ATTN_WIDTH // ATTN_HEAD_DIM
ATTN_KV_HEADS = 2

SPLIT_SIZES = (RET_HEADS * RET_QK_DIM, RET_HEADS * RET_QK_DIM, RET_WIDTH, RET_WIDTH,
               ATTN_WIDTH, ATTN_KV_HEADS * ATTN_HEAD_DIM, ATTN_KV_HEADS * ATTN_HEAD_DIM)
SPLIT_POINTS = tuple(int(s) for s in np.cumsum(SPLIT_SIZES)[:-1])
IN_WIDTH = sum(SPLIT_SIZES)

N_GROUPS = 8
EXPERTS_PER_GROUP = 8
N_EXPERTS = N_GROUPS * EXPERTS_PER_GROUP
TOP_K = 2
D_EXPERT = D_MODEL // 2
EXPERT_BLOCK = 128

kernel_name = "hybrid_retention_axial_gqa_hmoe_block"


def rmsnorm(x, g, eps=NORM_EPS):
    xf = x.astype(jnp.float32)
    y = xf * lax.rsqrt(jnp.mean(xf * xf, axis=-1, keepdims=True) + eps)
    return y.astype(x.dtype) * g


def rope_1d(x, ang):
    n = ang.shape[-1]
    cos = jnp.cos(ang)[None, :, None, :].astype(x.dtype)
    sin = jnp.sin(ang)[None, :, None, :].astype(x.dtype)
    x1, x2 = x[..., :n], x[..., n:]
    return jnp.concatenate([x1 * cos - x2 * sin, x2 * cos + x1 * sin], axis=-1)


def axial_rope(x, pos_row, pos_col):
    half = x.shape[-1] // 2
    freqs = ROPE_THETA ** (-jnp.arange(0, half, 2, dtype=jnp.float32) / half)
    xr = rope_1d(x[..., :half], pos_row[:, None] * freqs[None, :])
    xc = rope_1d(x[..., half:], pos_col[:, None] * freqs[None, :])
    return jnp.concatenate([xr, xc], axis=-1)


def retention_direction(q, k, v, log_gamma, strict):
    B, L, H, dk = q.shape
    dv = v.shape[-1]
    n = L // CHUNK
    q = q.reshape(B, n, CHUNK, H, dk)
    k = k.reshape(B, n, CHUNK, H, dk)
    v = v.reshape(B, n, CHUNK, H, dv)
    i = jnp.arange(CHUNK, dtype=jnp.float32)
    diff = i[:, None] - i[None, :]
    mask = (diff > 0) if strict else (diff >= 0)
    dec = jnp.where(mask[None], jnp.exp(log_gamma[:, None, None] * jnp.maximum(diff, 0.0)[None]), 0.0)
    scores = jnp.einsum('bnihd,bnjhd->bnhij', q, k) * dec
    intra = jnp.einsum('bnhij,bnjhe->bnihe', scores, v)
    k_dec = k * jnp.exp(log_gamma[None, :] * (CHUNK - 1 - i)[:, None])[None, None, :, :, None]
    upd = jnp.einsum('bnjhd,bnjhe->bnhde', k_dec, v)
    chunk_decay = jnp.exp(log_gamma * CHUNK)[None, :, None, None]

    def step(state, u):
        return chunk_decay * state + u, state

    _, s_prev = lax.scan(step, jnp.zeros((B, H, dk, dv), upd.dtype), jnp.moveaxis(upd, 1, 0))
    s_prev = jnp.moveaxis(s_prev, 0, 1)
    q_dec = q * jnp.exp(log_gamma[None, :] * (i + 1.0)[:, None])[None, None, :, :, None]
    cross = jnp.einsum('bnihd,bnhde->bnihe', q_dec, s_prev)
    return (intra + cross).reshape(B, L, H, dv)


def bidirectional_retention(q, k, v, logit_fwd, logit_bwd):
    lg_f = jax.nn.log_sigmoid(logit_fwd.astype(jnp.float32))
    lg_b = jax.nn.log_sigmoid(logit_bwd.astype(jnp.float32))
    fwd = retention_direction(q, k, v, lg_f, False)
    flip = lambda t: jnp.flip(t, axis=1)
    bwd = flip(retention_direction(flip(q), flip(k), flip(v), lg_b, True))
    return fwd + bwd


def block_gqa_attention(q, k, v):
    B, Lq, Hq, dh = q.shape
    Hkv = k.shape[2]
    G = Hq // Hkv
    nb = Lq // Q_BLOCK
    qb = jnp.moveaxis(q.reshape(B, nb, Q_BLOCK, Hkv, G, dh), 1, 0)
    scale = dh ** -0.5

    def one_block(qblk):
        s = jnp.einsum('bqkgd,bskd->bkgqs', qblk, k).astype(jnp.float32) * scale
        p = jax.nn.softmax(s, axis=-1).astype(v.dtype)
        return jnp.einsum('bkgqs,bskd->bqkgd', p, v)

    o = lax.map(one_block, qb)
    return jnp.moveaxis(o, 0, 1).reshape(B, Lq, Hq * dh)


def hierarchical_moe(xt, wg, bg, we, be, w_gate, w_up, w_down):
    T, D = xt.shape
    xf = xt.astype(jnp.float32)
    g_prob = jax.nn.softmax(xf @ wg.astype(jnp.float32) + bg.astype(jnp.float32), axis=-1)
    g_w, g_idx = lax.top_k(g_prob, 1)
    e_logits = (xf @ we.astype(jnp.float32) + be.astype(jnp.float32)).reshape(T, N_GROUPS, EXPERTS_PER_GROUP)
    e_in = jnp.take_along_axis(e_logits, g_idx[:, :, None], axis=1)[:, 0]
    top_v, top_i = lax.top_k(e_in, TOP_K)
    gate = g_w * jax.nn.softmax(top_v, axis=-1)
    expert = (g_idx * EXPERTS_PER_GROUP + top_i).reshape(-1)
    token = jnp.repeat(jnp.arange(T), TOP_K)
    weight = gate.reshape(-1)
    tk = T * TOP_K
    order = jnp.argsort(expert, stable=True)
    se, st, sw = expert[order], token[order], weight[order]
    counts = jax.ops.segment_sum(jnp.ones_like(expert), expert, num_segments=N_EXPERTS)
    starts = jnp.cumsum(counts) - counts
    padded = (counts + EXPERT_BLOCK - 1) // EXPERT_BLOCK * EXPERT_BLOCK
    pad_end = jnp.cumsum(padded)
    pad_start = pad_end - padded
    dest = pad_start[se] + jnp.arange(tk) - starts[se]
    n_blk = -(-tk // EXPERT_BLOCK) + N_EXPERTS
    rows = n_blk * EXPERT_BLOCK
    buf = jnp.zeros((rows, D), xt.dtype).at[dest].set(xt[st])
    blk_expert = jnp.minimum(
        jnp.searchsorted(pad_end, jnp.arange(n_blk) * EXPERT_BLOCK, side='right'), N_EXPERTS - 1)

    def run_block(args):
        xb, e = args
        hb = jax.nn.silu(xb @ w_gate[e]) * (xb @ w_up[e])
        return hb @ w_down[e]

    out = lax.map(run_block, (buf.reshape(n_blk, EXPERT_BLOCK, D), blk_expert)).reshape(rows, D)
    return jnp.zeros((T, D), xt.dtype).at[st].add(out[dest] * sw[:, None].astype(xt.dtype))


def setup_inputs(seed: int = 0) -> dict:
    key = jax.random.key(seed)
    ks = jax.random.split(key, 20)
    nrm = lambda k, shape, scale: jax.random.normal(k, shape, jnp.float32) * scale
    gain = lambda k, shape: 1.0 + 0.02 * jax.random.normal(k, shape, jnp.float32)
    a = np.arange(5, 5 + RET_HEADS, dtype=np.float64)
    base_logit = jnp.asarray(np.log(2.0 ** a - 1.0).astype(np.float32))
    return {
        "x": nrm(ks[0], (BATCH, SEQ, D_MODEL), 1.0),
        "meta_tokens": nrm(ks[1], (N_META, D_MODEL), 1.0),
        "norm_mix_g": gain(ks[2], (DEPTH, D_MODEL)),
        "w_in": nrm(ks[3], (DEPTH, D_MODEL, IN_WIDTH), D_MODEL ** -0.5),
        "ret_decay_logit_fwd": base_logit[None] + nrm(ks[4], (DEPTH, RET_HEADS), 0.05),
        "ret_decay_logit_bwd": base_logit[None] + nrm(ks[5], (DEPTH, RET_HEADS), 0.05),
        "ret_norm_g": gain(ks[6], (DEPTH, RET_WIDTH)),
        "attn_q_norm_g": gain(ks[7], (DEPTH, ATTN_HEAD_DIM)),
        "attn_k_norm_g": gain(ks[8], (DEPTH, ATTN_HEAD_DIM)),
        "attn_out_norm_g": gain(ks[9], (DEPTH, ATTN_WIDTH)),
        "w_out": nrm(ks[10], (DEPTH, MIX_WIDTH, D_MODEL), MIX_WIDTH ** -0.5),
        "norm_ffn_g": gain(ks[11], (DEPTH, D_MODEL)),
        "router_group_w": nrm(ks[12], (DEPTH, D_MODEL, N_GROUPS), D_MODEL ** -0.5),
        "router_group_b": nrm(ks[13], (DEPTH, N_GROUPS), 0.01),
        "router_expert_w": nrm(ks[14], (DEPTH, D_MODEL, N_EXPERTS), D_MODEL ** -0.5),
        "router_expert_b": nrm(ks[15], (DEPTH, N_EXPERTS), 0.01),
        "expert_w_gate": nrm(ks[16], (DEPTH, N_EXPERTS, D_MODEL, D_EXPERT), D_MODEL ** -0.5),
        "expert_w_up": nrm(ks[17], (DEPTH, N_EXPERTS, D_MODEL, D_EXPERT), D_MODEL ** -0.5),
        "expert_w_down": nrm(ks[18], (DEPTH, N_EXPERTS, D_EXPERT, D_MODEL), D_EXPERT ** -0.5),
        "norm_final_g": gain(ks[19], (D_MODEL,)),
    }


def reference(x, meta_tokens, norm_mix_g, w_in, ret_decay_logit_fwd, ret_decay_logit_bwd,
              ret_norm_g, attn_q_norm_g, attn_k_norm_g, attn_out_norm_g, w_out, norm_ffn_g,
              router_group_w, router_group_b, router_expert_w, router_expert_b,
              expert_w_gate, expert_w_up, expert_w_down, norm_final_g):
    B, n_tok, D = x.shape
    rows = n_tok // GRID_W
    Lp = n_tok + PREFIX
    h = jnp.concatenate([
        jnp.zeros((B, PAD, D), x.dtype),
        jnp.broadcast_to(meta_tokens.astype(x.dtype)[None], (B, N_META, D)),
        x], axis=1)
    row_ids = jnp.repeat(jnp.arange(rows), GRID_W).astype(jnp.float32)
    col_ids = jnp.tile(jnp.arange(GRID_W), rows).astype(jnp.float32)
    zeros_p = jnp.zeros((PREFIX,), jnp.float32)
    pos_row = jnp.concatenate([zeros_p, row_ids])
    pos_col = jnp.concatenate([zeros_p, col_ids])
    key_valid = (jnp.arange(Lp) >= PAD).astype(x.dtype)[None, :, None, None]

    for l in range(DEPTH):
        a = rmsnorm(h, norm_mix_g[l])
        proj = a @ w_in[l]
        rq, rk, rv, rg, aq, ak, av = jnp.split(proj, SPLIT_POINTS, axis=-1)

        rq = axial_rope(rq.reshape(B, Lp, RET_HEADS, RET_QK_DIM), pos_row, pos_col)
        rk = axial_rope(rk.reshape(B, Lp, RET_HEADS, RET_QK_DIM), pos_row, pos_col)
        rk = rk * (RET_QK_DIM ** -0.5) * key_valid
        rv = rv.reshape(B, Lp, RET_HEADS, RET_V_DIM)
        ro = bidirectional_retention(rq, rk, rv, ret_decay_logit_fwd[l], ret_decay_logit_bwd[l])
        ro = ro.astype(jnp.float32)
        mu = jnp.mean(ro, axis=-1, keepdims=True)
        var = jnp.mean(jnp.square(ro - mu), axis=-1, keepdims=True)
        ro = ((ro - mu) * lax.rsqrt(var + 1e-5)).reshape(B, Lp, RET_WIDTH).astype(x.dtype)
        ret_out = jax.nn.silu(rg) * (ro * ret_norm_g[l])

        aq = axial_rope(rmsnorm(aq.reshape(B, Lp, ATTN_HEADS, ATTN_HEAD_DIM), attn_q_norm_g[l]),
                        pos_row, pos_col)
        ak = axial_rope(rmsnorm(ak.reshape(B, Lp, ATTN_KV_HEADS, ATTN_HEAD_DIM), attn_k_norm_g[l]),
                        pos_row, pos_col)[:, PAD:]
        av = av.reshape(B, Lp, ATTN_KV_HEADS, ATTN_HEAD_DIM)[:, PAD:]
        attn_out = rmsnorm(block_gqa_attention(aq, ak, av), attn_out_norm_g[l])

        mix = jnp.concatenate([ret_out, attn_out], axis=-1) @ w_out[l]
        h = h + mix

        f = rmsnorm(h, norm_ffn_g[l]).reshape(B * Lp, D)
        h = h + hierarchical_moe(f, router_group_w[l], router_group_b[l], router_expert_w[l],
                                 router_expert_b[l], expert_w_gate[l], expert_w_up[l],
                                 expert_w_down[l]).reshape(B, Lp, D)

    return rmsnorm(h, norm_final_g)[:, PREFIX:]
```

```cpp
#include <hip/hip_runtime.h>
#include <cstdio>
#include <cstdint>

#ifndef MK_N_LAUNCHES
#define MK_N_LAUNCHES 1
#endif

#if MK_N_LAUNCHES == 1 && !defined(ONLY_PHASE)
#define MK_TABLE_EVERY_PHASE false
#else
#define MK_TABLE_EVERY_PHASE true
#endif
#define LAS __attribute__((address_space(3)))
typedef unsigned short bf16_t;
typedef short bf16x8 __attribute__((ext_vector_type(8)));
typedef short s16x4 __attribute__((ext_vector_type(4)));
typedef float f32x4 __attribute__((ext_vector_type(4)));
typedef float f32x2 __attribute__((ext_vector_type(2)));
typedef float f32x16 __attribute__((ext_vector_type(16)));
typedef float f32x8 __attribute__((ext_vector_type(8)));
typedef unsigned u32x4 __attribute__((ext_vector_type(4)));
typedef unsigned u32x2 __attribute__((ext_vector_type(2)));

constexpr int DM = 2048, SEQ = 8192, NMETA = 16, PREFIX = 128, PADN = 112, LP = SEQ + PREFIX  , MROWS = 8448  ;
constexpr int INW = 4608, NEXP = 64, DEXP = 1024;
constexpr int C_RQ = 0, C_RK = 512, C_RV = 1024, C_RG = 2048, C_AQ = 3072, C_AK = 4096, C_AV = 4352;
constexpr int NKEY = 8320;
constexpr int NCHUNK = 65;
constexpr int NTHREADS = 512;
constexpr int LDS_BYTES = 147456;
constexpr int LDS_MISC = 131072;

constexpr size_t al256(size_t x) { return (x + 255) / 256 * 256; }
constexpr size_t WS_CTL = 0;
constexpr size_t CTL_BYTES = 65536;
constexpr size_t CTL_CNT = 16384;
constexpr size_t CTL_XRANK = 20480;
constexpr size_t WS_TABQ = WS_CTL + CTL_BYTES;
constexpr size_t WS_TABR = WS_TABQ + 128 * 32 * 8;
constexpr size_t WS_WR = al256(WS_TABR + 128 * 16 * 8);
constexpr size_t WS_ABF = al256(WS_WR + (size_t)DM * 80 * 4);
constexpr size_t WS_WIN = al256(WS_ABF + (size_t)MROWS * DM * 2);
constexpr size_t WS_WOUT = al256(WS_WIN + (size_t)INW * DM * 2);
constexpr size_t WS_PROJ = al256(WS_WOUT + (size_t)DM * DM * 2);
constexpr size_t WS_RQ = al256(WS_PROJ + (size_t)MROWS * INW * 2);
constexpr size_t WS_RK = al256(WS_RQ + (size_t)MROWS * 512 * 2);
constexpr size_t WS_AQ = al256(WS_RK + (size_t)MROWS * 512 * 2);
constexpr size_t WS_AK = al256(WS_AQ + (size_t)SEQ * 1024 * 2);
constexpr size_t WS_AV = al256(WS_AK + (size_t)NKEY * 256 * 2);
constexpr size_t WS_UST = al256(WS_AV + (size_t)NKEY * 256 * 2);
constexpr size_t WS_SST = al256(WS_UST + (size_t)NCHUNK * 8 * 2 * 8192 * 4);
constexpr size_t WS_ATTO = al256(WS_SST + (size_t)NCHUNK * 8 * 2 * 8192 * 2);
constexpr size_t WS_MIXA = al256(WS_ATTO + (size_t)SEQ * 1024 * 4);
constexpr size_t WS_H1 = al256(WS_MIXA + (size_t)SEQ * DM * 2);
constexpr size_t WS_FBF = al256(WS_H1 + (size_t)SEQ * DM * 4);
constexpr size_t WS_ROUTE = al256(WS_FBF + (size_t)SEQ * DM * 2);
constexpr size_t WS_LIST = al256(WS_ROUTE + (size_t)SEQ * 32);
constexpr size_t WS_HB = al256(WS_LIST + (size_t)NEXP * SEQ * 4);
constexpr size_t WS_YB = al256(WS_HB + (size_t)16384 * 1024 * 2);
constexpr size_t WS_END = al256(WS_YB + (size_t)16384 * 2048 * 2);

struct Params {
    const float* x; const float* meta; const float* norm_mix_g; const float* w_in; const float* lf; const float* lb;
    const float* ret_norm_g; const float* gq; const float* gk; const float* attn_out_g; const float* w_out; const float* norm_ffn_g;
    const float* wg; const float* bg; const float* we; const float* be; const float* w_gate; const float* w_up; const float* w_down;
    const float* norm_final_g; float* out; unsigned char* ws; int ph_lo, ph_hi;
};

#define XB_TMO      128
#define XB_XCNT(j)  (256  + 64 * (j))
#define XB_XSUB(j)  (1280 + 64 * (j))
#define XB_XGEN(j)  (2304 + 64 * (j))
#define XB_TOP      3328
#define XB_TOPGEN   3392
#define XCD_BAR_WORDS 3456
#define XB_SPIN_CAP (1u << 18)

__device__ __forceinline__ unsigned xb_ld(unsigned* p)              { return __hip_atomic_load(p, __ATOMIC_RELAXED, __HIP_MEMORY_SCOPE_AGENT); }
__device__ __forceinline__ unsigned xb_add(unsigned* p, unsigned v) { return __hip_atomic_fetch_add(p, v, __ATOMIC_RELAXED, __HIP_MEMORY_SCOPE_AGENT); }
__device__ __forceinline__ unsigned xb_xcc_id() { return (unsigned)__builtin_amdgcn_s_getreg((3 << 11) | 20) & 0xFu; }
#define XB_SPIN(cond, bar) do { unsigned _sp = 0; while (cond) { __builtin_amdgcn_s_sleep(1); \
    if ((++_sp & 255u) == 0u) { if (xb_ld(&(bar)[XB_TMO])) break; if (_sp > XB_SPIN_CAP) { atomicAdd(&(bar)[XB_TMO], 1u); break; } } } } while (0)

struct XcdBarrier { unsigned* bar; unsigned x; volatile LAS unsigned* st; };

__device__ __forceinline__ XcdBarrier xcd_barrier_post(unsigned* bar, volatile LAS unsigned* st) {
    XcdBarrier b; b.bar = bar; b.x = xb_xcc_id(); b.st = st;
    if (threadIdx.x == 0) (void)xb_add(&bar[XB_XCNT(b.x)], 1u);
    return b;
}
__device__ __forceinline__ void xcd_barrier_complete(unsigned* bar, unsigned x, unsigned& nloc, unsigned& nx) {
    const unsigned G = gridDim.x * gridDim.y * gridDim.z;
    unsigned sum, cnt, mine, sp = 0u;
    for (;;) {
        sum = 0u; cnt = 0u; mine = 0u;
#pragma unroll
        for (unsigned j = 0; j < 16; ++j) { const unsigned c = xb_ld(&bar[XB_XCNT(j)]); sum += c; cnt += (c > 0u) ? 1u : 0u; mine = (j == x) ? c : mine; }
        if (sum == G) break;
        __builtin_amdgcn_s_sleep(1);
        if ((++sp & 255u) == 0u) { if (xb_ld(&bar[XB_TMO])) break; if (sp > XB_SPIN_CAP) { atomicAdd(&bar[XB_TMO], 1u); break; } }
    }
    nloc = mine > 0u ? mine : 1u; nx = cnt > 0u ? cnt : 1u;
}
__device__ __forceinline__ void xcd_barrier(const XcdBarrier& b) {
    asm volatile("s_waitcnt vmcnt(0)" ::: "memory");
    __syncthreads();
    if (threadIdx.x == 0) {
        unsigned* bar = b.bar;
        __builtin_amdgcn_s_waitcnt(0);
        unsigned nloc = b.st[0], nx = b.st[1];
        if (nloc == 0u) { xcd_barrier_complete(bar, b.x, nloc, nx); b.st[0] = nloc; b.st[1] = nx; }
        const unsigned old = xb_add(&bar[XB_XSUB(b.x)], 1u);
        const unsigned gen = old / nloc;
        if (old + 1u == (gen + 1u) * nloc) {
            __builtin_amdgcn_fence(__ATOMIC_RELEASE, "agent");
            asm volatile("s_waitcnt vmcnt(0)" ::: "memory");
            const unsigned og = xb_add(&bar[XB_TOP], 1u);
            const unsigned tg = og / nx;
            if (og + 1u == (tg + 1u) * nx) xb_add(&bar[XB_TOPGEN], 1u);
            else XB_SPIN(xb_ld(&bar[XB_TOPGEN]) == tg, bar);
            __builtin_amdgcn_fence(__ATOMIC_ACQUIRE, "agent");
            xb_add(&bar[XB_XGEN(b.x)], 1u);
            asm volatile("s_waitcnt vmcnt(0)" ::: "memory");
        } else {
            XB_SPIN(xb_ld(&bar[XB_XGEN(b.x)]) == gen, bar);
            __builtin_amdgcn_fence(__ATOMIC_ACQUIRE, "agent");
            asm volatile("s_waitcnt vmcnt(0)" ::: "memory");
        }
    }
    __syncthreads();
}

__device__ __forceinline__ unsigned cvt_pk_bf16(float lo, float hi) { unsigned r; asm volatile("v_cvt_pk_bf16_f32 %0, %1, %2" : "=v"(r) : "v"(lo), "v"(hi)); return r; }
__device__ __forceinline__ unsigned pk4_fp8(float a, float b, float c, float d) { int v = __builtin_amdgcn_cvt_pk_fp8_f32(a, b, 0, false); v = __builtin_amdgcn_cvt_pk_fp8_f32(c, d, v, true); return (unsigned)v; }
__device__ __forceinline__ float bf_lo(unsigned w) { return __uint_as_float(w << 16); }
__device__ __forceinline__ float bf_hi(unsigned w) { return __uint_as_float(w & 0xffff0000u); }
__device__ __forceinline__ float bf2f(bf16_t b) { return __uint_as_float(((unsigned)b) << 16); }
__device__ __forceinline__ float wave_sum(float v) {
#pragma unroll
    for (int o = 32; o >= 1; o >>= 1) v += __shfl_xor(v, o);
    return v;
}
__device__ __forceinline__ float fsilu(float v) { return v / (1.0f + __expf(-v)); }
__device__ __forceinline__ bf16x8 tr_frag(LAS unsigned char* lanebase, int stride, int k0, int c0) {
    LAS unsigned char* a = lanebase + k0 * stride + c0 * 2;
    const s16x4 lo = __builtin_amdgcn_ds_read_tr16_b64_v4i16((LAS s16x4*)a), hi = __builtin_amdgcn_ds_read_tr16_b64_v4i16((LAS s16x4*)(a + 16 * stride));
    return (bf16x8){lo[0], lo[1], lo[2], lo[3], hi[0], hi[1], hi[2], hi[3]};
}
__device__ __forceinline__ int tr_lane_off(int lane, int stride) { const int i = lane & 15, g = lane >> 4; return (4 * g + (i >> 2)) * stride + (i & 3) * 8; }

namespace pg8 {
constexpr int BM = 256, BK = 64, HALF = 128, HTB = HALF * BK * 2, STAGE_BYTES = 8 * HTB, NXCD = 8, WGM = 8;
__host__ __device__ __forceinline__ int lds_byte(int r, int c) { const int st = (r >> 4) * 2 + (c >> 5), rr = r & 15, cc = c & 31, ob = rr * 64 + cc * 2; return st * 1024 + (ob ^ (((ob >> 9) & 1) << 5)); }
__host__ __device__ __forceinline__ void stage_rc(int b, int& R, int& C) { const int st = b / 1024, sb = b % 1024, swz = sb ^ (((sb >> 9) & 1) << 5); R = (st >> 1) * 16 + swz / 64; C = (st & 1) * 32 + (swz % 64) / 2; }
__host__ __device__ __forceinline__ int perm32(int rho) { const int n = rho >> 4, i = rho & 15; return 8 * (i >> 2) + 4 * n + (i & 3); }

struct Unit { int pm, pn; const char* B; int aux; };

struct StaticOrder {
    int nM, nN, nwg, G, c, K; const char* Bt;
    __device__ void init(int M, int N, int K_, const void* Bt_, int G_, int c_) { nM = M / BM; nN = N / BM; nwg = nM * nN; G = G_; c = c_; K = K_; Bt = (const char*)Bt_; }
    __device__ __forceinline__ bool next(int i, Unit& u) const {
        const long L = (long)i * G + c; if (L >= nwg) return false;
        int wgid = (int)L; { const int q = nwg / NXCD, r = nwg % NXCD, xcd = wgid % NXCD, off = wgid / NXCD; wgid = (xcd < r ? xcd * (q + 1) : r * (q + 1) + (xcd - r) * q) + off; }
        const int nig = WGM * nN, gid = wgid / nig, fm = gid * WGM, gsz = (nM - fm) < WGM ? (nM - fm) : WGM;
        u.pm = fm + ((wgid % nig) % gsz); u.pn = (wgid % nig) / gsz; u.B = Bt + (size_t)u.pn * BM * K * 2; u.aux = 0; return true;
    }
    __device__ __forceinline__ unsigned a_row_off(const Unit& u, int row) const { return (unsigned)(u.pm * BM + row) * (unsigned)(K * 2); }
};

struct EpiBf16 {
    static constexpr bool MID = false; static constexpr bool PERM = true;
    bf16_t* O; int ldc;
    __device__ __forceinline__ void operator()(const f32x4 (&acc)[2][2][4][2], const Unit& u, int wr, int wc, int fr, int fq) const {
        const int row0 = u.pm * BM + wr * 64 + fr; const int col0 = u.pn * BM + wc * 32 + 8 * fq;
#pragma unroll
        for (int ai = 0; ai < 2; ++ai)
#pragma unroll
            for (int m = 0; m < 4; ++m) { bf16_t* rowp = O + (size_t)(row0 + ai * HALF + m * 16) * ldc + col0;
#pragma unroll
                for (int bj = 0; bj < 2; ++bj) { const f32x4 v0 = acc[ai][bj][m][0], v1 = acc[ai][bj][m][1];
                    u32x4 w; w.x = cvt_pk_bf16(v0[0], v0[1]); w.y = cvt_pk_bf16(v0[2], v0[3]); w.z = cvt_pk_bf16(v1[0], v1[1]); w.w = cvt_pk_bf16(v1[2], v1[3]);
                    *(u32x4*)(rowp + bj * HALF) = w; } }
    }
};
struct EpiBf16Res {
    static constexpr bool MID = false; static constexpr bool PERM = true;
    bf16_t* O; const float* base; int ldc;
    __device__ __forceinline__ void operator()(const f32x4 (&acc)[2][2][4][2], const Unit& u, int wr, int wc, int fr, int fq) const {
        const int row0 = u.pm * BM + wr * 64 + fr; const int col0 = u.pn * BM + wc * 32 + 8 * fq;
#pragma unroll
        for (int ai = 0; ai < 2; ++ai)
#pragma unroll
            for (int m = 0; m < 4; ++m) { const size_t off = (size_t)(row0 + ai * HALF + m * 16) * ldc + col0;
#pragma unroll
                for (int bj = 0; bj < 2; ++bj) { const f32x4 v0 = acc[ai][bj][m][0] + *(const f32x4*)(base + off + bj * HALF), v1 = acc[ai][bj][m][1] + *(const f32x4*)(base + off + bj * HALF + 4);
                    u32x4 w; w.x = cvt_pk_bf16(v0[0], v0[1]); w.y = cvt_pk_bf16(v0[2], v0[3]); w.z = cvt_pk_bf16(v1[0], v1[1]); w.w = cvt_pk_bf16(v1[2], v1[3]);
                    *(u32x4*)(O + off + bj * HALF) = w; } }
    }
};
struct EpiBf16ResMid {
    static constexpr bool MID = true; static constexpr bool PERM = true;
    bf16_t* O; const float* base; int ldc; const float* ssq; LAS float* rs;
    __device__ __forceinline__ void begin_unit(const Unit& u, int tid) const {
        if (tid < BM) { const float* s = ssq + (size_t)(u.pm * BM + tid) * 16; const f32x4 s0 = *(const f32x4*)(s), s1 = *(const f32x4*)(s + 4), s2 = *(const f32x4*)(s + 8), s3 = *(const f32x4*)(s + 12);
            const float ss = ((s0[0] + s0[1]) + (s0[2] + s0[3])) + ((s1[0] + s1[1]) + (s1[2] + s1[3])) + ((s2[0] + s2[1]) + (s2[2] + s2[3])) + ((s3[0] + s3[1]) + (s3[2] + s3[3]));
            rs[tid] = rsqrtf(ss * (1.0f / 1024.0f) + 1e-6f); }
        asm volatile("s_waitcnt lgkmcnt(0)" ::: "memory");
    }
    __device__ __forceinline__ void warm(const Unit& u, int tid, LAS unsigned char* dump) const {
        int tt = tid; asm volatile("" : "+v"(tt));
        LAS unsigned* d = (LAS unsigned*)(dump + (tt >> 6) * 256);
#pragma unroll
        for (int i = 0; i < 4; ++i) { const int L = tt + 512 * i;
            __builtin_amdgcn_global_load_lds((const unsigned*)(base + (size_t)(u.pm * BM + (L >> 3)) * ldc + u.pn * BM + (L & 7) * 32), d, 4, 0, 0); }
    }
    __device__ __forceinline__ void mid(f32x4 (&acc)[2][2][4][2], int wr, int fr) const {
#pragma unroll
        for (int ai = 0; ai < 2; ++ai)
#pragma unroll
            for (int m = 0; m < 4; ++m) { const float s = rs[ai * HALF + wr * 64 + m * 16 + fr];
#pragma unroll
                for (int bj = 0; bj < 2; ++bj)
#pragma unroll
                    for (int n = 0; n < 2; ++n) acc[ai][bj][m][n] = acc[ai][bj][m][n] * s; }
    }
    __device__ __forceinline__ void operator()(const f32x4 (&acc)[2][2][4][2], const Unit& u, int wr, int wc, int fr, int fq) const {
        const int row0 = u.pm * BM + wr * 64 + fr; const int col0 = u.pn * BM + wc * 32 + 8 * fq;
#pragma unroll
        for (int ai = 0; ai < 2; ++ai)
#pragma unroll
            for (int m = 0; m < 4; ++m) { const size_t off = (size_t)(row0 + ai * HALF + m * 16) * ldc + col0;
#pragma unroll
                for (int bj = 0; bj < 2; ++bj) { const f32x4 v0 = acc[ai][bj][m][0] + *(const f32x4*)(base + off + bj * HALF), v1 = acc[ai][bj][m][1] + *(const f32x4*)(base + off + bj * HALF + 4);
                    u32x4 w; w.x = cvt_pk_bf16(v0[0], v0[1]); w.y = cvt_pk_bf16(v0[2], v0[3]); w.z = cvt_pk_bf16(v1[0], v1[1]); w.w = cvt_pk_bf16(v1[2], v1[3]);
                    *(u32x4*)(O + off + bj * HALF) = w; } }
    }
};
struct EpiF32Res {
    static constexpr bool MID = false; static constexpr bool PERM = false;
    float* C; const float* base; int ldc;
    __device__ __forceinline__ void operator()(const f32x4 (&acc)[2][2][4][2], const Unit& u, int wr, int wc, int fr, int fq) const {
        const int row0 = u.pm * BM + wr * 64 + fr, col0 = u.pn * BM + wc * 32 + 4 * fq;
#pragma unroll
        for (int ai = 0; ai < 2; ++ai)
#pragma unroll
            for (int m = 0; m < 4; ++m) { const size_t off = (size_t)(row0 + ai * HALF + m * 16) * ldc + col0;
#pragma unroll
                for (int bj = 0; bj < 2; ++bj)
#pragma unroll
                    for (int n = 0; n < 2; ++n) { const f32x4 bs = *(const f32x4*)(base + off + bj * HALF + n * 16); *(f32x4*)(C + off + bj * HALF + n * 16) = acc[ai][bj][m][n] + bs; } }
    }
};
struct EpiSwiGLU {
    static constexpr bool MID = false; static constexpr bool PERM = false;
    bf16_t* H;
    __device__ __forceinline__ void operator()(const f32x4 (&acc)[2][2][4][2], const Unit& u, int wr, int wc, int fr, int fq) const {
        const int row0 = u.pm * BM + wr * 64 + fr;
#pragma unroll
        for (int ai = 0; ai < 2; ++ai)
#pragma unroll
            for (int m = 0; m < 4; ++m) { bf16_t* rowp = H + (size_t)(row0 + ai * HALF + m * 16) * DEXP;
#pragma unroll
                for (int bj = 0; bj < 2; ++bj) { const int G = u.pn * 8 + bj * 4 + wc; const f32x4 g = acc[ai][bj][m][0], up = acc[ai][bj][m][1];
                    u32x2 w; w.x = cvt_pk_bf16(fsilu(g[0]) * up[0], fsilu(g[1]) * up[1]); w.y = cvt_pk_bf16(fsilu(g[2]) * up[2], fsilu(g[3]) * up[3]);
                    *(u32x2*)(rowp + G * 16 + 4 * fq) = w; } }
    }
};

template <int K, class Epi, class Sched>
__device__ __forceinline__ void gemm_phase(LAS unsigned char* lds, const char* Abase, const Sched& S, const Epi& E) {
    const int tid = threadIdx.x, wid = __builtin_amdgcn_readfirstlane(tid >> 6), lane = tid & 63, wr = wid >> 2, wc = wid & 3, fr = lane & 15, fq = lane >> 4;
    constexpr int nt = K / BK;
    int sR[2], sC[2]; unsigned voffB[2];
#pragma unroll
    for (int i = 0; i < 2; ++i) { int R, C; stage_rc(tid * 16 + i * 8192, R, C); sR[i] = R; sC[i] = C; const int Rb = Epi::PERM ? ((R & ~31) + perm32(R & 31)) : R; voffB[i] = (unsigned)(Rb * K + C) * 2u; }
    constexpr size_t kstep = (size_t)(BK * 2);
    constexpr size_t hstep = (size_t)HALF * K * 2;
    const unsigned ldsw = (unsigned)wid * 1024u;
    const int aoff = lds_byte(wr * 64 + fr, fq * 8), boff = lds_byte(wc * 32 + fr, fq * 8);
#define PG8_SA(b, h) (((b) * 2 + (h)) * HTB)
#define PG8_SB(b, h) ((4 + (b) * 2 + (h)) * HTB)
#define PG8_STAGE_B(bufoff, gbase) do { _Pragma("unroll") for (int _i = 0; _i < 2; ++_i) \
        __builtin_amdgcn_global_load_lds((const unsigned*)((const char*)(gbase) + voffB[_i]), (LAS unsigned*)(lds + (bufoff) + ldsw + _i * 8192), 16, 0, 0); } while (0)
#define PG8_STAGE_A(bufoff, gbase, o0, o1) do { \
        __builtin_amdgcn_global_load_lds((const unsigned*)((const char*)(gbase) + (o0)), (LAS unsigned*)(lds + (bufoff) + ldsw), 16, 0, 0); \
        __builtin_amdgcn_global_load_lds((const unsigned*)((const char*)(gbase) + (o1)), (LAS unsigned*)(lds + (bufoff) + ldsw + 8192), 16, 0, 0); } while (0)
#define PG8_LDA(dst, b, h) do { _Pragma("unroll") for (int m = 0; m < 4; ++m) _Pragma("unroll") for (int k = 0; k < 2; ++k) dst[m][k] = *(const LAS bf16x8*)(lds + PG8_SA(b, h) + aoff + m * 2048 + k * 1024); } while (0)
#define PG8_LDB(dst, b, h) do { _Pragma("unroll") for (int n = 0; n < 2; ++n) _Pragma("unroll") for (int k = 0; k < 2; ++k) dst[n][k] = *(const LAS bf16x8*)(lds + PG8_SB(b, h) + boff + n * 2048 + k * 1024); } while (0)
#define PG8_MMA(ai, bj, At, Bt) do { __builtin_amdgcn_s_setprio(1); _Pragma("unroll") for (int m = 0; m < 4; ++m) _Pragma("unroll") for (int n = 0; n < 2; ++n) _Pragma("unroll") for (int k = 0; k < 2; ++k) \
        acc[ai][bj][m][n] = __builtin_amdgcn_mfma_f32_16x16x32_bf16(Bt[n][k], At[m][k], acc[ai][bj][m][n], 0, 0, 0); __builtin_amdgcn_s_setprio(0); } while (0)
#define PG8_WAIT_V(n) asm volatile("s_waitcnt vmcnt(" #n ")" ::: "memory")
#define PG8_WAIT_L(n) asm volatile("s_waitcnt lgkmcnt(" #n ")" ::: "memory")
#define PG8_BAR __builtin_amdgcn_s_barrier()
#define PG8_SCHED __builtin_amdgcn_sched_barrier(0)
    Unit cur, nxt; int ui = 0;
    __syncthreads();
    if (!S.next(0, cur)) return;
    f32x4 acc[2][2][4][2];
#pragma unroll
    for (int a = 0; a < 2; ++a)
#pragma unroll
        for (int b = 0; b < 2; ++b)
#pragma unroll
            for (int m = 0; m < 4; ++m)
#pragma unroll
                for (int n = 0; n < 2; ++n) acc[a][b][m][n] = (f32x4){0.f, 0.f, 0.f, 0.f};
    bf16x8 At[4][2], B0[2][2], B1[2][2];
    unsigned ca00, ca01, ca10, ca11, na00, na01, na10, na11;
    ca00 = S.a_row_off(cur, sR[0]) + sC[0] * 2; ca01 = S.a_row_off(cur, sR[1]) + sC[1] * 2;
    ca10 = S.a_row_off(cur, HALF + sR[0]) + sC[0] * 2; ca11 = S.a_row_off(cur, HALF + sR[1]) + sC[1] * 2;
    const char* cB = cur.B;
    PG8_STAGE_B(PG8_SB(0, 0), cB); PG8_STAGE_A(PG8_SA(0, 0), Abase, ca00, ca01); PG8_STAGE_B(PG8_SB(0, 1), cB + hstep); PG8_STAGE_A(PG8_SA(0, 1), Abase, ca10, ca11);
    if constexpr (Epi::MID) E.begin_unit(cur, tid);
    if (wr == 1) PG8_BAR;
    PG8_WAIT_V(4); PG8_BAR;
    PG8_STAGE_B(PG8_SB(1, 0), cB + kstep); PG8_STAGE_A(PG8_SA(1, 0), Abase + kstep, ca00, ca01); PG8_STAGE_B(PG8_SB(1, 1), cB + hstep + kstep);
    PG8_WAIT_V(6); PG8_BAR;
    for (;;) {
        const bool has_next = S.next(ui + 1, nxt);
        if (has_next) {
            na00 = S.a_row_off(nxt, sR[0]) + sC[0] * 2; na01 = S.a_row_off(nxt, sR[1]) + sC[1] * 2;
            na10 = S.a_row_off(nxt, HALF + sR[0]) + sC[0] * 2; na11 = S.a_row_off(nxt, HALF + sR[1]) + sC[1] * 2;
        } else { na00 = ca00; na01 = ca01; na10 = ca10; na11 = ca11; }
        const char* nB = has_next ? nxt.B : cB;
        for (int t = 0; t < nt; t += 2) {
            if constexpr (Epi::MID) { if (t == nt / 2) { E.mid(acc, wr, fr); E.warm(cur, tid, lds + 131072 + 8192); } }
            const bool last = (t == nt - 2);
            const char* a1 = Abase + (size_t)(t + 1) * kstep;
            const char* a2 = last ? Abase : Abase + (size_t)(t + 2) * kstep; const char* b2 = last ? nB : cB + (size_t)(t + 2) * kstep;
            const char* a3 = a2 + kstep; const char* b3 = b2 + kstep;
            const unsigned x00 = last ? na00 : ca00, x01 = last ? na01 : ca01, x10 = last ? na10 : ca10, x11 = last ? na11 : ca11;
            PG8_LDB(B0, 0, 0); PG8_SCHED; PG8_LDA(At, 0, 0); PG8_STAGE_A(PG8_SA(1, 1), a1, ca10, ca11);
            PG8_WAIT_L(8); PG8_BAR; PG8_WAIT_L(0); PG8_MMA(0, 0, At, B0); PG8_BAR; PG8_SCHED;
            PG8_LDB(B1, 0, 1); PG8_STAGE_B(PG8_SB(0, 0), b2);
            PG8_BAR; PG8_WAIT_L(0); PG8_MMA(0, 1, At, B1); PG8_BAR;
            PG8_LDA(At, 0, 1); PG8_STAGE_A(PG8_SA(0, 0), a2, x00, x01);
            PG8_BAR; PG8_WAIT_L(0); PG8_MMA(1, 0, At, B0); PG8_BAR; PG8_SCHED;
            PG8_STAGE_B(PG8_SB(0, 1), b2 + hstep);
            PG8_WAIT_V(6); PG8_BAR; PG8_MMA(1, 1, At, B1); PG8_BAR;
            PG8_LDB(B0, 1, 0); PG8_SCHED; PG8_LDA(At, 1, 0); PG8_STAGE_A(PG8_SA(0, 1), a2, x10, x11);
            PG8_WAIT_L(8); PG8_BAR; PG8_WAIT_L(0); PG8_MMA(0, 0, At, B0); PG8_BAR; PG8_SCHED;
            PG8_LDB(B1, 1, 1); PG8_STAGE_B(PG8_SB(1, 0), b3);
            PG8_BAR; PG8_WAIT_L(0); PG8_MMA(0, 1, At, B1); PG8_BAR;
            PG8_LDA(At, 1, 1); PG8_STAGE_A(PG8_SA(1, 0), a3, x00, x01);
            PG8_BAR; PG8_WAIT_L(0); PG8_MMA(1, 0, At, B0); PG8_BAR; PG8_SCHED;
            PG8_STAGE_B(PG8_SB(1, 1), b3 + hstep);
            PG8_WAIT_V(6); PG8_BAR; PG8_MMA(1, 1, At, B1); PG8_BAR;
        }
        E(acc, cur, wr, wc, fr, fq);
        if (!has_next) break;
#pragma unroll
        for (int a = 0; a < 2; ++a)
#pragma unroll
            for (int b = 0; b < 2; ++b)
#pragma unroll
                for (int m = 0; m < 4; ++m)
#pragma unroll
                    for (int n = 0; n < 2; ++n) acc[a][b][m][n] = (f32x4){0.f, 0.f, 0.f, 0.f};
        cur = nxt; cB = nB; ca00 = na00; ca01 = na01; ca10 = na10; ca11 = na11; ++ui;
        if constexpr (Epi::MID) E.begin_unit(cur, tid);
    }
    PG8_WAIT_V(0);
    if (wr == 0) PG8_BAR;
    PG8_BAR;
    asm volatile("" ::: "memory"); __syncthreads();
#undef PG8_SA
#undef PG8_SB
#undef PG8_STAGE_A
#undef PG8_STAGE_B
#undef PG8_LDA
#undef PG8_LDB
#undef PG8_MMA
#undef PG8_WAIT_V
#undef PG8_WAIT_L
#undef PG8_BAR
#undef PG8_SCHED
}
}

namespace att {
constexpr int D = 128, NW = 8, QBLK = 32, KVBLK = 64;
constexpr float SCALE = 0.088388347648318440f;
constexpr float THR = 8.f;
constexpr int LDQ = 1024, LDK = 256, LDM = 2048;
constexpr size_t SHM_V = KVBLK * D * 2, SHM_K = KVBLK * D * 2, SHM_ATTN = 2 * SHM_V + 2 * SHM_K + NW * 64 * 4;
#define KSWZ(row, colB) ((row) * 256 + ((colB) ^ (((row) & 7) << 4)))
#define SBAR() __builtin_amdgcn_sched_barrier(0)
__device__ __forceinline__ int crow(int r, int hi) { return (r & 3) + 8 * (r >> 2) + 4 * hi; }
__device__ __forceinline__ void partialSM(f32x16& p0, f32x16& p1, float& m_reg, float& mn, float& alpha) {
  constexpr float C = SCALE * 1.4426950408889634f;
  float pmax = p0[0]; for (int r = 1; r < 16; ++r) pmax = fmaxf(pmax, p0[r]); for (int r = 0; r < 16; ++r) pmax = fmaxf(pmax, p1[r]);
  { auto rr = __builtin_amdgcn_permlane32_swap(__float_as_uint(pmax), __float_as_uint(pmax), false, false);
    pmax = fmaxf(__uint_as_float(rr[0]), __uint_as_float(rr[1])); }
  if (__builtin_expect(__all(pmax - m_reg <= THR / SCALE), 1)) { mn = m_reg; alpha = 1.f; }
  else { mn = fmaxf(m_reg, pmax); alpha = __builtin_amdgcn_exp2f((m_reg - mn) * C); m_reg = mn; }
  float mnC = -mn * C;
  for (int r = 0; r < 16; ++r) p0[r] = fmaf(p0[r], C, mnC); for (int r = 0; r < 16; ++r) p1[r] = fmaf(p1[r], C, mnC);
  for (int r = 0; r < 16; ++r) p0[r] = __builtin_amdgcn_exp2f(p0[r]);
}
__device__ __forceinline__ void finishSM(f32x16& p0, f32x16& p1, float alpha, float& l_reg, bf16x8& pa0, bf16x8& pa1, bf16x8& pa2, bf16x8& pa3) {
  for (int r = 0; r < 16; ++r) p1[r] = __builtin_amdgcn_exp2f(p1[r]);
  float ps = 0; for (int r = 0; r < 16; ++r) ps += p0[r]; for (int r = 0; r < 16; ++r) ps += p1[r];
  { auto rr = __builtin_amdgcn_permlane32_swap(__float_as_uint(ps), __float_as_uint(ps), false, false);
    ps = __uint_as_float(rr[0]) + __uint_as_float(rr[1]); }
  l_reg = l_reg * alpha + ps;
#define PK4(P, BASE, OUT) do { unsigned a0 = cvt_pk_bf16(P[BASE + 0], P[BASE + 1]), a1 = cvt_pk_bf16(P[BASE + 2], P[BASE + 3]);   \
    unsigned b0 = cvt_pk_bf16(P[BASE + 4], P[BASE + 5]), b1 = cvt_pk_bf16(P[BASE + 6], P[BASE + 7]);                              \
    auto r0 = __builtin_amdgcn_permlane32_swap(a0, b0, false, false); auto r1 = __builtin_amdgcn_permlane32_swap(a1, b1, false, false); \
    u32x4 w = {r0[0], r1[0], r0[1], r1[1]}; OUT = *reinterpret_cast<bf16x8*>(&w); } while (0)
  PK4(p0, 0, pa0); PK4(p0, 8, pa1); PK4(p1, 0, pa2); PK4(p1, 8, pa3);
#undef PK4
}
__device__ __forceinline__ void qkt(f32x16& p0, f32x16& p1, const bf16_t* Ks, const bf16x8* qr, int r32, int hi) {
  p0 = f32x16{}; p1 = f32x16{};
  for (int d0 = 0; d0 < 8; ++d0) { int cb = (d0 * 16 + hi * 8) * 2;
    bf16x8 b0 = *reinterpret_cast<const bf16x8*>((const char*)Ks + KSWZ(r32, cb));
    bf16x8 b1 = *reinterpret_cast<const bf16x8*>((const char*)Ks + KSWZ(32 + r32, cb));
    p0 = __builtin_amdgcn_mfma_f32_32x32x16_bf16(b0, qr[d0], p0, 0, 0, 0);
    p1 = __builtin_amdgcn_mfma_f32_32x32x16_bf16(b1, qr[d0], p1, 0, 0, 0); }
}
__device__ __forceinline__ int v_st(int k, int c) { const int kk = (k & ~0xC) | ((k & 4) << 1) | ((k & 8) >> 1); return ((kk >> 3) * 4 + (c >> 5)) * 512 + ((kk & 7) * 32 + (c & 31)) * 2; }
__device__ __forceinline__ int v_rd_base(int lane) { return ((lane & 3) << 3) | (((lane >> 2) & 3) << 6) | (((lane >> 4) & 1) << 5) | (((lane >> 5) & 1) << 8); }
constexpr int v_rd_off(int d0, int ks, int half) { return d0 * 512 + ks * 4096 + half * 2048; }
template <int OFF> __device__ __forceinline__ s16x4 tr_read(int vb) {
  s16x4 r; asm volatile("ds_read_b64_tr_b16 %0, %1 offset:%2" : "=&v"(r) : "v"(vb), "i"(OFF) : "memory"); return r;
}
template <int D0> __device__ __forceinline__ void pv_one(f32x16& od, int vb, bf16x8 pa0, bf16x8 pa1, bf16x8 pa2, bf16x8 pa3) {
  const s16x4 l0 = tr_read<v_rd_off(D0, 0, 0)>(vb), h0 = tr_read<v_rd_off(D0, 0, 1)>(vb), l1 = tr_read<v_rd_off(D0, 1, 0)>(vb), h1 = tr_read<v_rd_off(D0, 1, 1)>(vb);
  const s16x4 l2 = tr_read<v_rd_off(D0, 2, 0)>(vb), h2 = tr_read<v_rd_off(D0, 2, 1)>(vb), l3 = tr_read<v_rd_off(D0, 3, 0)>(vb), h3 = tr_read<v_rd_off(D0, 3, 1)>(vb);
  asm volatile("s_waitcnt lgkmcnt(0)" ::: "memory"); SBAR();
#define PK(L, H) (bf16x8){L[0], L[1], L[2], L[3], H[0], H[1], H[2], H[3]}
  od = __builtin_amdgcn_mfma_f32_32x32x16_bf16(pa0, PK(l0, h0), od, 0, 0, 0);
  od = __builtin_amdgcn_mfma_f32_32x32x16_bf16(pa1, PK(l1, h1), od, 0, 0, 0);
  od = __builtin_amdgcn_mfma_f32_32x32x16_bf16(pa2, PK(l2, h2), od, 0, 0, 0);
  od = __builtin_amdgcn_mfma_f32_32x32x16_bf16(pa3, PK(l3, h3), od, 0, 0, 0);
#undef PK
}
__device__ __forceinline__ void pv_d0(f32x16* o, int vb, bf16x8 pa0, bf16x8 pa1, bf16x8 pa2, bf16x8 pa3) {
  pv_one<0>(o[0], vb, pa0, pa1, pa2, pa3); pv_one<1>(o[1], vb, pa0, pa1, pa2, pa3); pv_one<2>(o[2], vb, pa0, pa1, pa2, pa3); pv_one<3>(o[3], vb, pa0, pa1, pa2, pa3);
}
__device__ __forceinline__ void attn_dense_body(const bf16_t* __restrict__ Qb, const bf16_t* __restrict__ Kh, const bf16_t* __restrict__ Vh,
                                                bf16_t* __restrict__ Ob, float* __restrict__ Sq, int seq, char* lds) {
  const int tid = threadIdx.x, wid = tid >> 6, lane = tid & 63, r32 = lane & 31, hi = lane >> 5;
  bf16_t* V_lds = (bf16_t*)lds; bf16_t* K_lds = (bf16_t*)(lds + 2 * SHM_V);
  float* ws = (float*)(lds + 2 * SHM_V + 2 * SHM_K) + wid * 64; float* li_l = ws; float* al_l = ws + 32;
  float m_reg = -1e30f, l_reg = 0; f32x16 o[4] = {}; bf16x8 qr[8];
  const bf16_t* Qw = Qb + (long)(wid * QBLK + r32) * LDQ + hi * 8;
#pragma unroll
  for (int d0 = 0; d0 < 8; ++d0) qr[d0] = *reinterpret_cast<const bf16x8*>(Qw + d0 * 16);
  const int sr = tid >> 4, sc = (tid & 15) * 8, vst0 = v_st(sr, sc), vst1 = v_st(32 + sr, sc);
  const int vb0 = (int)(uintptr_t)V_lds + v_rd_base(lane);
  struct { bf16x8 vs0, vs1, ks0, ks1; } sr_[2];
#define SLOAD(i, k0) do { sr_[i].vs0 = *reinterpret_cast<const bf16x8*>(&Vh[(long)((k0) + sr) * LDK + sc]); sr_[i].vs1 = *reinterpret_cast<const bf16x8*>(&Vh[(long)((k0) + 32 + sr) * LDK + sc]); \
    sr_[i].ks0 = *reinterpret_cast<const bf16x8*>(&Kh[(long)((k0) + sr) * LDK + sc]); sr_[i].ks1 = *reinterpret_cast<const bf16x8*>(&Kh[(long)((k0) + 32 + sr) * LDK + sc]); } while (0)
#define SWRITE(b, i) do { *(bf16x8*)((char*)V_lds + (b) * SHM_V + vst0) = sr_[i].vs0;          \
    *(bf16x8*)((char*)V_lds + (b) * SHM_V + vst1) = sr_[i].vs1; int kc = sc * 2;               \
    *(bf16x8*)((char*)K_lds + (b) * SHM_K + KSWZ(sr, kc)) = sr_[i].ks0;                       \
    *(bf16x8*)((char*)K_lds + (b) * SHM_K + KSWZ(32 + sr, kc)) = sr_[i].ks1; } while (0)
#define SWAIT() asm volatile("s_waitcnt vmcnt(4)" ::: "memory")
#define RESC(a) do { if (__any((a) < 1.f)) { if (hi == 0) al_l[r32] = (a); asm volatile("s_waitcnt lgkmcnt(0)" ::: "memory"); \
    for (int d = 0; d < 4; ++d) for (int r = 0; r < 16; ++r) o[d][r] *= al_l[crow(r, hi)]; } } while (0)
  f32x16 pA0, pA1, pB0, pB1; float mnA, mnB, alA, alB; bf16x8 pa0, pa1, pa2, pa3; const int NT = seq / KVBLK;
  constexpr int SE = 0, SO = 1;
  SLOAD(SE, 0); asm volatile("s_waitcnt vmcnt(0)" ::: "memory"); SWRITE(0, SE); __syncthreads();
  qkt(pA0, pA1, K_lds, qr, r32, hi);
#pragma unroll
  for (int r = 8; r < 16; ++r) pA0[r] = -1e30f;
#pragma unroll
  for (int r = 0; r < 16; ++r) pA1[r] = -1e30f;
  partialSM(pA0, pA1, m_reg, mnA, alA);
  SLOAD(SO, KVBLK); if (2 < NT) SLOAD(SE, 2 * KVBLK);
  SWAIT(); SWRITE(1, SO); __syncthreads();
  for (int j = 1; j + 1 < NT; j += 2) {
    SBAR(); qkt(pB0, pB1, (bf16_t*)((char*)K_lds + SHM_K), qr, r32, hi);
    finishSM(pA0, pA1, alA, l_reg, pa0, pa1, pa2, pa3); SBAR();
    SLOAD(SO, (j + 2) * KVBLK); SBAR();
    pv_d0(o, vb0, pa0, pa1, pa2, pa3); partialSM(pB0, pB1, m_reg, mnB, alB);
    __syncthreads(); SWAIT(); SWRITE(0, SE);
    RESC(alB); __syncthreads();
    SBAR(); qkt(pA0, pA1, K_lds, qr, r32, hi);
    finishSM(pB0, pB1, alB, l_reg, pa0, pa1, pa2, pa3); SBAR();
    if (j + 3 < NT) SLOAD(SE, (j + 3) * KVBLK); SBAR();
    pv_d0(o, vb0 + (int)SHM_V, pa0, pa1, pa2, pa3); partialSM(pA0, pA1, m_reg, mnA, alA);
    __syncthreads(); SWAIT(); SWRITE(1, SO);
    RESC(alA); __syncthreads();
  }
  SBAR(); qkt(pB0, pB1, (bf16_t*)((char*)K_lds + SHM_K), qr, r32, hi);
#pragma unroll
  for (int r = 0; r < 16; ++r) { pB0[r] = -1e30f; pB1[r] = -1e30f; }
  finishSM(pA0, pA1, alA, l_reg, pa0, pa1, pa2, pa3); SBAR();
  pv_d0(o, vb0, pa0, pa1, pa2, pa3); partialSM(pB0, pB1, m_reg, mnB, alB);
  __syncthreads(); RESC(alB);
  finishSM(pB0, pB1, alB, l_reg, pa0, pa1, pa2, pa3); SBAR();
  pv_d0(o, vb0 + (int)SHM_V, pa0, pa1, pa2, pa3);
  if (hi == 0) li_l[r32] = l_reg; asm volatile("s_waitcnt lgkmcnt(0)" ::: "memory");
  float rli[16];
#pragma unroll
  for (int r = 0; r < 16; ++r) rli[r] = __builtin_amdgcn_rcpf(li_l[crow(r, hi)]);
  __syncthreads();
  char* st = lds + wid * 16384;
  {
    int ln = lane; asm volatile("" : "+v"(ln));
    const int r32e = ln & 31, hie = ln >> 5;
    char* sb[4];
#pragma unroll
    for (int c = 0; c < 4; ++c) sb[c] = st + hie * 2048 + ((((r32e >> 2) ^ (4 * hie)) ^ c) * 16) + (r32e & 3) * 4;
#pragma unroll
    for (int r = 0; r < 16; ++r)
#pragma unroll
      for (int d0 = 0; d0 < 4; ++d0) *(float*)(sb[r & 3] + ((r & 3) + 8 * (r >> 2)) * 512 + ((d0 ^ (r >> 2)) * 128)) = o[d0][r] * rli[r]; }
  asm volatile("s_waitcnt lgkmcnt(0)" ::: "memory");
  { int ln = lane; asm volatile("" : "+v"(ln)); const int row = ln >> 1, half = ln & 1; float ss = 0.f;
    bf16_t* dst = Ob + (long)(wid * QBLK + row) * LDM + half * 64;
#pragma unroll
    for (int i = 0; i < 16; i += 2) { const f32x4 a = *(const f32x4*)(st + row * 512 + (((half * 16 + i) ^ row) & 31) * 16), b = *(const f32x4*)(st + row * 512 + (((half * 16 + i + 1) ^ row) & 31) * 16);
      ss += a[0] * a[0] + a[1] * a[1] + a[2] * a[2] + a[3] * a[3] + b[0] * b[0] + b[1] * b[1] + b[2] * b[2] + b[3] * b[3];
      u32x4 w; w.x = cvt_pk_bf16(a[0], a[1]); w.y = cvt_pk_bf16(a[2], a[3]); w.z = cvt_pk_bf16(b[0], b[1]); w.w = cvt_pk_bf16(b[2], b[3]);
      *(u32x4*)(dst + i * 4) = w; }
    Sq[(long)(wid * QBLK + row) * 16 + half] = ss; }
  __syncthreads();
#undef SLOAD
#undef SWRITE
#undef SWAIT
#undef RESC
}
}

struct Ctx { int tid, lane, wave, G, bid; LAS unsigned char* lds; unsigned char* ws; int xcc, xrank; };

template <class DstRow>
__device__ __forceinline__ void cvt_tile(const float* __restrict__ src, int C, int r0, int c0, bf16_t* __restrict__ dst, int ldd, DstRow dstrow, LAS float* tile, int dk0, const float* __restrict__ rs) {
    const int t = threadIdx.x, c4 = (t & 63) * 4, rr = t >> 6;
    f32x4 v[8];
#pragma unroll
    for (int i = 0; i < 8; ++i) { v[i] = *(const f32x4*)(src + (size_t)(r0 + rr + 8 * i) * C + c0 + c4); if (rs) v[i] = v[i] * rs[r0 + rr + 8 * i]; }
    __syncthreads();
#pragma unroll
    for (int i = 0; i < 8; ++i) *(LAS f32x4*)(tile + (rr + 8 * i) * 260 + c4) = v[i];
    __syncthreads();
    const int dc = t & 255, half = t >> 8;
    bf16_t* drow = dst + (size_t)dstrow(c0 + dc) * ldd + dk0 + 32 * half;
#pragma unroll
    for (int k8 = 0; k8 < 4; ++k8) { u32x4 w;
#pragma unroll
        for (int j = 0; j < 4; ++j) { const float lo = tile[(32 * half + 8 * k8 + 2 * j) * 260 + dc], hi = tile[(32 * half + 8 * k8 + 2 * j + 1) * 260 + dc]; w[j] = cvt_pk_bf16(lo, hi); }
        *(u32x4*)(drow + 8 * k8) = w; }
}
__device__ __forceinline__ void cvt_load(f32x4 (&v)[8], const float* __restrict__ src, int C, int r0, int c0) {
    const int t = threadIdx.x, c4 = (t & 63) * 4, rr = t >> 6;
#pragma unroll
    for (int i = 0; i < 8; ++i) v[i] = *(const f32x4*)(src + (size_t)(r0 + rr + 8 * i) * C + c0 + c4);
}
__device__ __forceinline__ void cvt_finish(const f32x4 (&v)[8], int c0, bf16_t* __restrict__ dst, int ldd, LAS float* tile, int dk0) {
    const int t = threadIdx.x, c4 = (t & 63) * 4, rr = t >> 6;
    __syncthreads();
#pragma unroll
    for (int i = 0; i < 8; ++i) *(LAS f32x4*)(tile + (rr + 8 * i) * 260 + c4) = v[i];
    __syncthreads();
    const int dc = t & 255, half = t >> 8;
    bf16_t* drow = dst + (size_t)(c0 + dc) * ldd + dk0 + 32 * half;
#pragma unroll
    for (int k8 = 0; k8 < 4; ++k8) { u32x4 w;
#pragma unroll
        for (int j = 0; j < 4; ++j) { const float lo = tile[(32 * half + 8 * k8 + 2 * j) * 260 + dc], hi = tile[(32 * half + 8 * k8 + 2 * j + 1) * 260 + dc]; w[j] = cvt_pk_bf16(lo, hi); }
        *(u32x4*)(drow + 8 * k8) = w; }
}
struct RowId { __device__ __forceinline__ int operator()(int c) const { return c; } };
struct RowGU { int add; __device__ __forceinline__ int operator()(int c) const { return 32 * (c >> 4) + add + (c & 15); } };

__device__ __forceinline__ void p0_prologue(const Params& p, const Ctx& F) {
    LAS float* tile = (LAS float*)F.lds;
    bf16_t* win = (bf16_t*)(F.ws + WS_WIN);
    constexpr int J_WIN = 32 * 18;
    {
        const int j0 = F.bid, j1 = j0 + F.G, j2 = j1 + F.G; f32x4 va[8], vb[8];
        if (j0 < J_WIN) cvt_load(va, p.w_in, INW, (j0 / 18) * 64, (j0 % 18) * 256);
        if (j1 < J_WIN) cvt_load(vb, p.w_in, INW, (j1 / 18) * 64, (j1 % 18) * 256);
        if (j0 < J_WIN) cvt_finish(va, (j0 % 18) * 256, win, DM, tile, (j0 / 18) * 64);
        if (j2 < J_WIN) cvt_load(va, p.w_in, INW, (j2 / 18) * 64, (j2 % 18) * 256);
        if (j1 < J_WIN) cvt_finish(vb, (j1 % 18) * 256, win, DM, tile, (j1 / 18) * 64);
        if (j2 < J_WIN) cvt_finish(va, (j2 % 18) * 256, win, DM, tile, (j2 / 18) * 64);
        for (int j = j2 + F.G; j < J_WIN; j += F.G) { const int tr = j / 18, tc = j % 18; cvt_tile(p.w_in, INW, tr * 64, tc * 256, win, DM, RowId{}, tile, tr * 64, nullptr); }
    }
    bf16_t* abf = (bf16_t*)(F.ws + WS_ABF);
    constexpr int RJ = 8;
    int r_lo = 0, r_n = 0; bool even = true;
    { const int G = F.G, base = (MROWS + RJ * J_WIN) / G; int sum = 0, lo = 0, mine = 0; bool ok = true;
      for (int c = 0; c < G; ++c) { const int tiles = c < J_WIN ? (J_WIN - 1 - c) / G + 1 : 0; const int rc = base - RJ * tiles; if (rc < 0) ok = false;
          if (c == F.bid) { lo = sum; mine = rc; } sum += rc; }
      const int rem = MROWS - sum;
      if (ok && rem >= 0 && rem <= G) { even = false; r_lo = lo + (F.bid < rem ? F.bid : rem); r_n = mine + (F.bid < rem ? 1 : 0); } }
    const int gw = even ? F.bid * 8 + F.wave : r_lo + F.wave, nw = even ? F.G * 8 : 8, n_end = even ? MROWS : r_lo + r_n;
    for (int n = gw; n < n_end; n += nw) {
        bf16_t* dst = abf + (size_t)n * DM;
        if (n < PADN || n >= LP) {
#pragma unroll
            for (int i = 0; i < 8; ++i) *(u32x2*)(dst + (F.lane + 64 * i) * 4) = (u32x2){0u, 0u};
        } else {
            const float* src = (n < PREFIX) ? p.meta + (size_t)(n - PADN) * DM : p.x + (size_t)(n - PREFIX) * DM;
            f32x4 v[8]; float ss = 0.f;
#pragma unroll
            for (int i = 0; i < 8; ++i) { v[i] = *(const f32x4*)(src + (F.lane + 64 * i) * 4); ss += v[i][0] * v[i][0] + v[i][1] * v[i][1] + v[i][2] * v[i][2] + v[i][3] * v[i][3]; }
            ss = wave_sum(ss); const float rstd = rsqrtf(ss * (1.0f / DM) + 1e-6f);
#pragma unroll
            for (int i = 0; i < 8; ++i) { const f32x4 g = *(const f32x4*)(p.norm_mix_g + (F.lane + 64 * i) * 4);
                u32x2 w; w.x = cvt_pk_bf16(v[i][0] * rstd * g[0], v[i][1] * rstd * g[1]); w.y = cvt_pk_bf16(v[i][2] * rstd * g[2], v[i][3] * rstd * g[3]);
                *(u32x2*)(dst + (F.lane + 64 * i) * 4) = w; }
        }
    }
    const int gt = F.bid * NTHREADS + F.tid, ntot = F.G * NTHREADS;
    f32x2* tabq = (f32x2*)(F.ws + WS_TABQ); f32x2* tabr = (f32x2*)(F.ws + WS_TABR);
    for (int i = gt; i < 128 * 48; i += ntot) {
        int pos, fi; float fr;
        if (i < 128 * 32) { pos = i >> 5; fi = i & 31; fr = exp2f(-(float)(2 * fi) * (13.287712379549449f / 64.0f)); }
        else { const int q = i - 128 * 32; pos = q >> 4; fi = q & 15; fr = exp2f(-(float)(2 * fi) * (13.287712379549449f / 32.0f)); }
        const float ang = (float)pos * fr; float rev = ang * 0.15915494309189535f; rev -= rintf(rev);
        const f32x2 cs = {__builtin_amdgcn_cosf(rev), __builtin_amdgcn_sinf(rev)};
        if (i < 128 * 32) tabq[i] = cs; else tabr[i - 128 * 32] = cs;
    }
}

__device__ __forceinline__ void p1_side_jobs(const Params& p, const Ctx& F, int nunits) {
    const int r = nunits % F.G, lo = r == 0 ? 0 : r, nid = F.G - lo;
    if (F.bid < lo) return;
    const int c = F.bid - lo;
    LAS float* tile = (LAS float*)F.lds; bf16_t* wout = (bf16_t*)(F.ws + WS_WOUT);
    for (int q = c; q < 32 * 8; q += nid) { const int tr = q / 8, tc = q % 8; cvt_tile(p.w_out, DM, tr * 64, tc * 256, wout, DM, RowId{}, tile, (tr * 64) ^ 1024, tr >= 16 ? p.attn_out_g - 1024 : nullptr); }
    const int gt = c * NTHREADS + F.tid, ntot = nid * NTHREADS;
    bf16_t* wrh = (bf16_t*)(F.ws + WS_WR);
    for (int i = gt; i < DM * 80; i += ntot) { const int j = i / DM, k = i % DM; const float g = p.norm_ffn_g[k];
        const float v = j < 8 ? g * p.wg[k * 8 + j] : (j < 72 ? g * p.we[k * 64 + (j - 8)] : 0.f);
        wrh[i] = (bf16_t)(cvt_pk_bf16(v, 0.f) & 0xffffu); }
}

__device__ __forceinline__ void p2_post(const Params& p, const Ctx& F) {
    const bf16_t* proj = (const bf16_t*)(F.ws + WS_PROJ);
    bf16_t* rq = (bf16_t*)(F.ws + WS_RQ); bf16_t* rk = (bf16_t*)(F.ws + WS_RK); bf16_t* aq = (bf16_t*)(F.ws + WS_AQ); bf16_t* ak = (bf16_t*)(F.ws + WS_AK); bf16_t* av = (bf16_t*)(F.ws + WS_AV);
    const f32x2* tabq = (const f32x2*)(F.ws + WS_TABQ); const f32x2* tabr = (const f32x2*)(F.ws + WS_TABR);
    const int lane = F.lane, tot = LP + 112, qb = tot / F.G, qr = tot % F.G;
    const int n_lo = F.bid * qb + (F.bid < qr ? F.bid : qr), n_hi = n_lo + qb + (F.bid < qr ? 1 : 0);
    for (int n = n_lo + F.wave; n < n_hi; n += 8) {
        if (n >= LP) {
            const int z = n - LP; const int slot = z < 48 ? 16 + z : 8256 + (z - 48);
            *(u32x2*)(ak + (size_t)slot * 256 + lane * 4) = (u32x2){0u, 0u}; *(u32x2*)(av + (size_t)slot * 256 + lane * 4) = (u32x2){0u, 0u};
            continue;
        }
        const bf16_t* pr = proj + (size_t)n * INW;
        int prow = 0, pcol = 0; if (n >= PREFIX) { const int t = n - PREFIX; prow = t >> 6; pcol = t & 63; }
        const int hd = lane >> 2, jr = (lane & 3) * 4, hh = lane >> 3, ja = (lane & 7) * 4, hk = hh < 2 ? hh : 0;
        const bf16_t* sr_ = pr + hd * 64 + jr; const bf16_t* sq_ = pr + C_AQ + hh * 128 + ja; const bf16_t* sk_ = pr + C_AK + hk * 128 + ja;
        const u32x2 ra1 = *(const u32x2*)(sr_), ra2 = *(const u32x2*)(sr_ + 16), rb1 = *(const u32x2*)(sr_ + 32), rb2 = *(const u32x2*)(sr_ + 48);
        const u32x2 qa1 = *(const u32x2*)(sq_), qa2 = *(const u32x2*)(sq_ + 32), qb1 = *(const u32x2*)(sq_ + 64), qb2 = *(const u32x2*)(sq_ + 96);
        const u32x2 ka1 = *(const u32x2*)(sk_), ka2 = *(const u32x2*)(sk_ + 32), kb1 = *(const u32x2*)(sk_ + 64), kb2 = *(const u32x2*)(sk_ + 96);
        const u32x2 vv = *(const u32x2*)(pr + C_AV + lane * 4);
        f32x2 trr[4], trc[4], tqr[4], tqc[4];
#pragma unroll
        for (int i = 0; i < 4; ++i) { trr[i] = tabr[prow * 16 + jr + i]; trc[i] = tabr[pcol * 16 + jr + i]; tqr[i] = tabq[prow * 32 + ja + i]; tqc[i] = tabq[pcol * 32 + ja + i]; }
        {
            const int j0 = jr; const u32x2 a1 = ra1, a2 = ra2, b1 = rb1, b2 = rb2;
            float x1r[4] = {bf_lo(a1.x), bf_hi(a1.x), bf_lo(a1.y), bf_hi(a1.y)}, x2r[4] = {bf_lo(a2.x), bf_hi(a2.x), bf_lo(a2.y), bf_hi(a2.y)};
            float x1c[4] = {bf_lo(b1.x), bf_hi(b1.x), bf_lo(b1.y), bf_hi(b1.y)}, x2c[4] = {bf_lo(b2.x), bf_hi(b2.x), bf_lo(b2.y), bf_hi(b2.y)};
            const float sc = hd >= 8 ? 0.125f : 1.0f;
            float o1r[4], o2r[4], o1c[4], o2c[4];
#pragma unroll
            for (int i = 0; i < 4; ++i) { const f32x2 cr = trr[i], cc = trc[i];
                o1r[i] = (x1r[i] * cr.x - x2r[i] * cr.y) * sc; o2r[i] = (x2r[i] * cr.x + x1r[i] * cr.y) * sc;
                o1c[i] = (x1c[i] * cc.x - x2c[i] * cc.y) * sc; o2c[i] = (x2c[i] * cc.x + x1c[i] * cc.y) * sc; }
            bf16_t* d = (hd >= 8 ? rk : rq) + (size_t)n * 512 + (hd & 7) * 64 + j0;
            *(u32x2*)(d) = (u32x2){cvt_pk_bf16(o1r[0], o1r[1]), cvt_pk_bf16(o1r[2], o1r[3])}; *(u32x2*)(d + 16) = (u32x2){cvt_pk_bf16(o2r[0], o2r[1]), cvt_pk_bf16(o2r[2], o2r[3])};
            *(u32x2*)(d + 32) = (u32x2){cvt_pk_bf16(o1c[0], o1c[1]), cvt_pk_bf16(o1c[2], o1c[3])}; *(u32x2*)(d + 48) = (u32x2){cvt_pk_bf16(o2c[0], o2c[1]), cvt_pk_bf16(o2c[2], o2c[3])};
        }
        if (n < PADN) continue;
        const int slot = n < PREFIX ? n - PADN : 64 + (n - PREFIX);
#pragma unroll
        for (int pass = 0; pass < 2; ++pass) {
            if (pass == 0 && n < PREFIX) continue;
            const int j0 = ja; const bool act = pass == 0 || hh < 2; const int hc = act ? hh : 0;
            const float* g = pass == 0 ? p.gq : p.gk;
            const u32x2 a1 = pass == 0 ? qa1 : ka1, a2 = pass == 0 ? qa2 : ka2, b1 = pass == 0 ? qb1 : kb1, b2 = pass == 0 ? qb2 : kb2;
            float x1r[4] = {bf_lo(a1.x), bf_hi(a1.x), bf_lo(a1.y), bf_hi(a1.y)}, x2r[4] = {bf_lo(a2.x), bf_hi(a2.x), bf_lo(a2.y), bf_hi(a2.y)};
            float x1c[4] = {bf_lo(b1.x), bf_hi(b1.x), bf_lo(b1.y), bf_hi(b1.y)}, x2c[4] = {bf_lo(b2.x), bf_hi(b2.x), bf_lo(b2.y), bf_hi(b2.y)};
            float ss = 0.f;
#pragma unroll
            for (int i = 0; i < 4; ++i) ss += x1r[i] * x1r[i] + x2r[i] * x2r[i] + x1c[i] * x1c[i] + x2c[i] * x2c[i];
            ss += __shfl_xor(ss, 1); ss += __shfl_xor(ss, 2); ss += __shfl_xor(ss, 4);
            const float rstd = rsqrtf(ss * (1.0f / 128.0f) + 1e-6f);
            float o1r[4], o2r[4], o1c[4], o2c[4];
#pragma unroll
            for (int i = 0; i < 4; ++i) { const f32x2 cr = tqr[i], cc = tqc[i];
                const float y1r = x1r[i] * rstd * g[j0 + i], y2r = x2r[i] * rstd * g[32 + j0 + i], y1c = x1c[i] * rstd * g[64 + j0 + i], y2c = x2c[i] * rstd * g[96 + j0 + i];
                o1r[i] = y1r * cr.x - y2r * cr.y; o2r[i] = y2r * cr.x + y1r * cr.y; o1c[i] = y1c * cc.x - y2c * cc.y; o2c[i] = y2c * cc.x + y1c * cc.y; }
            if (act) { bf16_t* d = pass == 0 ? aq + (size_t)(n - PREFIX) * 1024 + hc * 128 + j0 : ak + (size_t)slot * 256 + hc * 128 + j0;
                *(u32x2*)(d) = (u32x2){cvt_pk_bf16(o1r[0], o1r[1]), cvt_pk_bf16(o1r[2], o1r[3])}; *(u32x2*)(d + 32) = (u32x2){cvt_pk_bf16(o2r[0], o2r[1]), cvt_pk_bf16(o2r[2], o2r[3])};
                *(u32x2*)(d + 64) = (u32x2){cvt_pk_bf16(o1c[0], o1c[1]), cvt_pk_bf16(o1c[2], o1c[3])}; *(u32x2*)(d + 96) = (u32x2){cvt_pk_bf16(o2c[0], o2c[1]), cvt_pk_bf16(o2c[2], o2c[3])}; }
        }
        *(u32x2*)(av + (size_t)slot * 256 + lane * 4) = vv;
    }
}

__device__ __forceinline__ float log2_gamma(float logit) { return -log1pf(__expf(-logit)) * 1.4426950408889634f; }

__device__ __forceinline__ void p3_ret_state(const Params& p, const Ctx& F) {
    const bf16_t* proj = (const bf16_t*)(F.ws + WS_PROJ); const bf16_t* rk = (const bf16_t*)(F.ws + WS_RK); float* ust = (float*)(F.ws + WS_UST);
    constexpr int VS = 288, KS = 160;
    constexpr unsigned OV = 0, OKF = 128 * VS, OKB = OKF + 128 * KS;
    const int t = F.tid, lane = F.lane, w = F.wave;
    LAS unsigned char* vl = F.lds + OV + tr_lane_off(lane, VS); LAS unsigned char* kfl = F.lds + OKF + tr_lane_off(lane, KS); LAS unsigned char* kbl = F.lds + OKB + tr_lane_off(lane, KS);
    u32x4 vraw[4], kraw[2];
#define P3_LOAD(uu) do { const int _c = (uu) >> 3, _h = (uu) & 7, _row = t >> 2; const bf16_t* _vs = proj + (size_t)(_c * 128 + _row) * INW + C_RV + _h * 128; const bf16_t* _ks = rk + (size_t)(_c * 128 + _row) * 512 + _h * 64; \
        _Pragma("unroll") for (int _i = 0; _i < 4; ++_i) vraw[_i] = *(const u32x4*)(_vs + ((t & 3) + 4 * _i) * 8); \
        _Pragma("unroll") for (int _i = 0; _i < 2; ++_i) kraw[_i] = *(const u32x4*)(_ks + ((t & 3) + 4 * _i) * 8); } while (0)
    if (F.bid < NCHUNK * 8) P3_LOAD(F.bid);
    for (int u = F.bid; u < NCHUNK * 8; u += F.G) {
        const int c = u >> 3, h = u & 7;
        const float lgf = log2_gamma(p.lf[h]), lgb = log2_gamma(p.lb[h]);
        __syncthreads();
        {   const int row = t >> 2;
#pragma unroll
            for (int i = 0; i < 4; ++i) { const int ch = (t & 3) + 4 * i; *(LAS u32x4*)(F.lds + OV + row * VS + ch * 16) = vraw[i]; }
            const float wf = exp2f(lgf * (float)(127 - row)), wb = exp2f(lgb * (float)row);
#pragma unroll
            for (int i = 0; i < 2; ++i) { const int ch = (t & 3) + 4 * i; const u32x4 kv = kraw[i]; u32x4 kf, kb;
#pragma unroll
                for (int q = 0; q < 4; ++q) { const float lo = bf_lo(kv[q]), hi = bf_hi(kv[q]); kf[q] = cvt_pk_bf16(lo * wf, hi * wf); kb[q] = cvt_pk_bf16(lo * wb, hi * wb); }
                *(LAS u32x4*)(F.lds + OKF + row * KS + ch * 16) = kf; *(LAS u32x4*)(F.lds + OKB + row * KS + ch * 16) = kb; }
        }
        if (u + F.G < NCHUNK * 8) P3_LOAD(u + F.G);
        __syncthreads();
        f32x4 af[4], ab[4];
#pragma unroll
        for (int i = 0; i < 4; ++i) { af[i] = (f32x4){0.f, 0.f, 0.f, 0.f}; ab[i] = (f32x4){0.f, 0.f, 0.f, 0.f}; }
#pragma unroll
        for (int s = 0; s < 4; ++s) {
            const bf16x8 a = tr_frag(vl, VS, 32 * s, 16 * w);
#pragma unroll
            for (int db = 0; db < 4; ++db) {
                const bf16x8 bf = tr_frag(kfl, KS, 32 * s, 16 * db), bb = tr_frag(kbl, KS, 32 * s, 16 * db);
                af[db] = __builtin_amdgcn_mfma_f32_16x16x32_bf16(a, bf, af[db], 0, 0, 0);
                ab[db] = __builtin_amdgcn_mfma_f32_16x16x32_bf16(a, bb, ab[db], 0, 0, 0);
            }
        }
        const int g = lane >> 4, r = lane & 15;
        float* of = ust + ((size_t)(c * 8 + h) * 2 + 0) * 8192; float* ob = of + 8192;
#pragma unroll
        for (int db = 0; db < 4; ++db)
#pragma unroll
            for (int reg = 0; reg < 4; ++reg) { const int e = 16 * w + 4 * g + reg, d = 16 * db + r; of[e * 64 + d] = af[db][reg]; ob[e * 64 + d] = ab[db][reg]; }
    }
}

#undef P3_LOAD
__device__ __forceinline__ void p4_ret_scan(const Params& p, const Ctx& F) {
    const float* ust = (const float*)(F.ws + WS_UST); bf16_t* sst = (bf16_t*)(F.ws + WS_SST);
    constexpr int CS = 8 * 2 * 8192;
    for (int idx = F.bid * NTHREADS + F.tid; idx < 8 * 2 * 8192; idx += F.G * NTHREADS) {
        const int dir = (idx >> 13) & 1, h = idx >> 14;
        const float lg = log2_gamma(dir ? p.lb[h] : p.lf[h]); const float g128 = exp2f(lg * 128.0f);
        float s = 0.f;
        float u[64];
        if (dir == 0) {
#pragma unroll
            for (int i = 0; i < 64; ++i) u[i] = ust[(size_t)i * CS + idx];
#pragma unroll
            for (int i = 0; i < 64; ++i) { s = g128 * s + u[i]; sst[(size_t)(i + 1) * CS + idx] = (bf16_t)(cvt_pk_bf16(s, 0.f) & 0xffffu); }
        } else {
#pragma unroll
            for (int i = 0; i < 64; ++i) u[i] = ust[(size_t)(64 - i) * CS + idx];
            sst[(size_t)64 * CS + idx] = 0;
#pragma unroll
            for (int i = 0; i < 64; ++i) { s = g128 * s + u[i]; if (63 - i >= 1) sst[(size_t)(63 - i) * CS + idx] = (bf16_t)(cvt_pk_bf16(s, 0.f) & 0xffffu); }
        }
    }
}

__device__ __forceinline__ void p5_ret_out(const Params& p, const Ctx& F) {
    const bf16_t* proj = (const bf16_t*)(F.ws + WS_PROJ); const bf16_t* rq = (const bf16_t*)(F.ws + WS_RQ); const bf16_t* rk = (const bf16_t*)(F.ws + WS_RK);
    const bf16_t* sst = (const bf16_t*)(F.ws + WS_SST); bf16_t* mixa = (bf16_t*)(F.ws + WS_MIXA);
    constexpr int VS = 288, RS = 144;
    constexpr unsigned OV = 0, OK_ = 128 * VS, OS = OK_ + 128 * RS, OT = OS + 128 * RS, OO = OT + 128 * RS; constexpr int OSTR = 272;
    const int t = F.tid, lane = F.lane, w = F.wave, g = lane >> 4, r = lane & 15;
    LAS unsigned char* vl = F.lds + OV + tr_lane_off(lane, VS);
    for (int u = F.bid; u < 64 * 8; u += F.G) {
        const int c = 1 + (u >> 3), h = u & 7;
        const float lgf = log2_gamma(p.lf[h]), lgb = log2_gamma(p.lb[h]);
        __syncthreads();
        {   const int row = t >> 2;
            const bf16_t* vsrc = proj + (size_t)(c * 128 + row) * INW + C_RV + h * 128;
#pragma unroll
            for (int i = 0; i < 4; ++i) { const int ch = (t & 3) + 4 * i; *(LAS u32x4*)(F.lds + OV + row * VS + ch * 16) = *(const u32x4*)(vsrc + ch * 8); }
            const bf16_t* ksrc = rk + (size_t)(c * 128 + row) * 512 + h * 64;
            const bf16_t* ssrc = sst + ((size_t)(c * 8 + h) * 2 + 0) * 8192 + row * 64; const bf16_t* tsrc = ssrc + 8192;
#pragma unroll
            for (int i = 0; i < 2; ++i) { const int ch = (t & 3) + 4 * i;
                *(LAS u32x4*)(F.lds + OK_ + row * RS + ch * 16) = *(const u32x4*)(ksrc + ch * 8);
                *(LAS u32x4*)(F.lds + OS + row * RS + ch * 16) = *(const u32x4*)(ssrc + ch * 8);
                *(LAS u32x4*)(F.lds + OT + row * RS + ch * 16) = *(const u32x4*)(tsrc + ch * 8); }
        }
        bf16x8 qf[2];
        { const bf16_t* qsrc = rq + (size_t)(c * 128 + 16 * w + r) * 512 + h * 64 + 8 * g; qf[0] = *(const bf16x8*)(qsrc); qf[1] = *(const bf16x8*)(qsrc + 32); }
        __syncthreads();
        f32x4 sc[8];
#pragma unroll
        for (int kb = 0; kb < 8; ++kb) { sc[kb] = (f32x4){0.f, 0.f, 0.f, 0.f};
#pragma unroll
            for (int ks = 0; ks < 2; ++ks) { const bf16x8 kf = *(const LAS bf16x8*)(F.lds + OK_ + (16 * kb + r) * RS + (32 * ks + 8 * g) * 2);
                sc[kb] = __builtin_amdgcn_mfma_f32_16x16x32_bf16(kf, qf[ks], sc[kb], 0, 0, 0); } }
        const int iq = 16 * w + r;
#pragma unroll
        for (int kb = 0; kb < 8; ++kb)
#pragma unroll
            for (int reg = 0; reg < 4; ++reg) { const int j = 16 * kb + 4 * g + reg, df = iq - j;
                const float dec = df >= 0 ? exp2f(lgf * (float)df) : exp2f(lgb * (float)(-df)); sc[kb][reg] *= dec; }
        bf16x8 pf[4];
#pragma unroll
        for (int s = 0; s < 4; ++s) { u32x4 wv; wv.x = cvt_pk_bf16(sc[2 * s][0], sc[2 * s][1]); wv.y = cvt_pk_bf16(sc[2 * s][2], sc[2 * s][3]);
            wv.z = cvt_pk_bf16(sc[2 * s + 1][0], sc[2 * s + 1][1]); wv.w = cvt_pk_bf16(sc[2 * s + 1][2], sc[2 * s + 1][3]); pf[s] = *reinterpret_cast<bf16x8*>(&wv); }
        float sf[4], sb[4];
#pragma unroll
        for (int reg = 0; reg < 4; ++reg) { const int i = 16 * w + 4 * g + reg; sf[reg] = exp2f(lgf * (float)(i + 1)); sb[reg] = exp2f(lgb * (float)(128 - i)); }
        f32x4 o[8];
#pragma unroll
        for (int eb = 0; eb < 8; ++eb) {
            f32x4 acc = (f32x4){0.f, 0.f, 0.f, 0.f};
#pragma unroll
            for (int s = 0; s < 4; ++s) { const bf16x8 vf = tr_frag(vl, VS, 32 * s, 16 * eb); acc = __builtin_amdgcn_mfma_f32_16x16x32_bf16(pf[s], vf, acc, 0, 0, 0); }
            f32x4 xs = (f32x4){0.f, 0.f, 0.f, 0.f}, xt = (f32x4){0.f, 0.f, 0.f, 0.f};
#pragma unroll
            for (int ks = 0; ks < 2; ++ks) {
                const bf16x8 sfr = *(const LAS bf16x8*)(F.lds + OS + (16 * eb + r) * RS + (32 * ks + 8 * g) * 2);
                const bf16x8 tfr = *(const LAS bf16x8*)(F.lds + OT + (16 * eb + r) * RS + (32 * ks + 8 * g) * 2);
                xs = __builtin_amdgcn_mfma_f32_16x16x32_bf16(qf[ks], sfr, xs, 0, 0, 0);
                xt = __builtin_amdgcn_mfma_f32_16x16x32_bf16(qf[ks], tfr, xt, 0, 0, 0); }
#pragma unroll
            for (int reg = 0; reg < 4; ++reg) acc[reg] += sf[reg] * xs[reg] + sb[reg] * xt[reg];
            o[eb] = acc;
        }
#pragma unroll
        for (int eb = 0; eb < 8; ++eb) { const int e = 16 * eb + r;
#pragma unroll
            for (int reg = 0; reg < 4; ++reg) { const int i = 16 * w + 4 * g + reg;
                *(LAS bf16_t*)(F.lds + OO + i * OSTR + e * 2) = (bf16_t)(cvt_pk_bf16(o[eb][reg], 0.f) & 0xffffu); } }
        u32x4 gq0, gq1, gq2, gq3;
        { const bf16_t* gsrc0 = proj + ((size_t)c * 128 + (t >> 2)) * INW + C_RG + h * 128 + (t & 3) * 8;
          gq0 = *(const u32x4*)(gsrc0); gq1 = *(const u32x4*)(gsrc0 + 32); gq2 = *(const u32x4*)(gsrc0 + 64); gq3 = *(const u32x4*)(gsrc0 + 96); }
        __syncthreads();
        {   const int row = t >> 2; const size_t n = (size_t)c * 128 + row;
            float s1 = 0.f, sq = 0.f;
#pragma unroll 4
            for (int k = 0; k < 16; ++k) { const u32x4 rv = *(const LAS u32x4*)(F.lds + OO + row * OSTR + k * 16);
#pragma unroll
                for (int q = 0; q < 4; ++q) { const float a = bf_lo(rv[q]), b = bf_hi(rv[q]); s1 += a + b; sq += a * a + b * b; } }
            const float mu = s1 * (1.0f / 128.0f); const float s2 = fmaxf(sq - 128.0f * mu * mu, 0.f);
            const float rstd = rsqrtf(s2 * (1.0f / 128.0f) + 1e-5f);
            bf16_t* dst = mixa + (n - PREFIX) * DM + 1024 + h * 128; const float* gnp = p.ret_norm_g + h * 128;
#pragma unroll 1
            for (int i = 0; i < 4; ++i) { const int ch = (t & 3) + 4 * i; const u32x4 gv = i == 0 ? gq0 : (i == 1 ? gq1 : (i == 2 ? gq2 : gq3)); const f32x4 g0 = *(const f32x4*)(gnp + ch * 8), g1 = *(const f32x4*)(gnp + ch * 8 + 4);
                const u32x4 yv = *(const LAS u32x4*)(F.lds + OO + row * OSTR + ch * 16); u32x4 ov;
                ov[0] = cvt_pk_bf16(fsilu(bf_lo(gv[0])) * ((bf_lo(yv[0]) - mu) * rstd * g0[0]), fsilu(bf_hi(gv[0])) * ((bf_hi(yv[0]) - mu) * rstd * g0[1]));
                ov[1] = cvt_pk_bf16(fsilu(bf_lo(gv[1])) * ((bf_lo(yv[1]) - mu) * rstd * g0[2]), fsilu(bf_hi(gv[1])) * ((bf_hi(yv[1]) - mu) * rstd * g0[3]));
                ov[2] = cvt_pk_bf16(fsilu(bf_lo(gv[2])) * ((bf_lo(yv[2]) - mu) * rstd * g1[0]), fsilu(bf_hi(gv[2])) * ((bf_hi(yv[2]) - mu) * rstd * g1[1]));
                ov[3] = cvt_pk_bf16(fsilu(bf_lo(gv[3])) * ((bf_lo(yv[3]) - mu) * rstd * g1[2]), fsilu(bf_hi(gv[3])) * ((bf_hi(yv[3]) - mu) * rstd * g1[3]));
                *(u32x4*)(dst + ch * 8) = ov; }
        }
    }
}

__device__ __forceinline__ void p5_attention(const Params& p, const Ctx& F) {
    const bf16_t* aq = (const bf16_t*)(F.ws + WS_AQ); const bf16_t* ak = (const bf16_t*)(F.ws + WS_AK); const bf16_t* av = (const bf16_t*)(F.ws + WS_AV);
    bf16_t* mixa = (bf16_t*)(F.ws + WS_MIXA); float* ssq = (float*)(F.ws + WS_ATTO);
    for (int u = F.bid; u < 32 * 8; u += F.G) {
        const int h = u & 7, qb = u >> 3, kvh = h >> 2;
        att::attn_dense_body(aq + (size_t)qb * 256 * 1024 + h * 128, ak + kvh * 128, av + kvh * 128, mixa + (size_t)qb * 256 * DM + h * 128, ssq + (size_t)qb * 256 * 16 + h * 2, NKEY, (char*)F.lds);
    }
}

__device__ __forceinline__ void p6_mixprep(const Params& p, const Ctx& F) {
    const float* ssq = (const float*)(F.ws + WS_ATTO); bf16_t* mixa = (bf16_t*)(F.ws + WS_MIXA);
    const int gw = F.bid * 8 + F.wave, nw = F.G * 8, lane = F.lane;
    for (int t = gw; t < SEQ; t += nw) {
        const f32x4 s0 = *(const f32x4*)(ssq + (size_t)t * 16), s1 = *(const f32x4*)(ssq + (size_t)t * 16 + 4), s2 = *(const f32x4*)(ssq + (size_t)t * 16 + 8), s3 = *(const f32x4*)(ssq + (size_t)t * 16 + 12);
        const float ss = ((s0[0] + s0[1]) + (s0[2] + s0[3])) + ((s1[0] + s1[1]) + (s1[2] + s1[3])) + ((s2[0] + s2[1]) + (s2[2] + s2[3])) + ((s3[0] + s3[1]) + (s3[2] + s3[3]));
        const float rstd = rsqrtf(ss * (1.0f / 1024.0f) + 1e-6f);
#pragma unroll
        for (int i = 0; i < 4; ++i) { const int c = (lane + 64 * i) * 4; const f32x4 g = *(const f32x4*)(p.attn_out_g + c); const u32x2 v = *(const u32x2*)(mixa + (size_t)t * DM + c);
            u32x2 w; w.x = cvt_pk_bf16(bf_lo(v.x) * rstd * g[0], bf_hi(v.x) * rstd * g[1]); w.y = cvt_pk_bf16(bf_lo(v.y) * rstd * g[2], bf_hi(v.y) * rstd * g[3]);
            *(u32x2*)(mixa + (size_t)t * DM + c) = w; }
    }
}

__device__ __forceinline__ void p8_router(const Params& p, const Ctx& F) {
    const bf16_t* h1 = (const bf16_t*)(F.ws + WS_H1); const bf16_t* wrh = (const bf16_t*)(F.ws + WS_WR); unsigned char* fbf = (unsigned char*)(F.ws + WS_FBF);
    unsigned* cnt = (unsigned*)(F.ws + WS_CTL + CTL_CNT); int* list = (int*)(F.ws + WS_LIST); unsigned* route = (unsigned*)(F.ws + WS_ROUTE);
    LAS float* part = (LAS float*)F.lds;
    LAS float* pss = (LAS float*)(F.lds + 8 * 32 * 80 * 4);
    LAS float* prs = pss + 8 * 32;
    const int lane = F.lane, w = F.wave, r = lane & 15, q = lane >> 4;
    for (int blk = F.bid; blk < SEQ / 32; blk += F.G) {
        const int t0 = blk * 32;
        f32x4 acc[2][5];
#pragma unroll
        for (int tl = 0; tl < 2; ++tl)
#pragma unroll
            for (int nb = 0; nb < 5; ++nb) acc[tl][nb] = (f32x4){0.f, 0.f, 0.f, 0.f};
        float ss[2] = {0.f, 0.f};
        const __amdgpu_buffer_rsrc_t hrs = __builtin_amdgcn_make_buffer_rsrc((void*)h1, 0, 0x7fffffff, 0x00020000);
        const __amdgpu_buffer_rsrc_t wrs = __builtin_amdgcn_make_buffer_rsrc((void*)wrh, 0, 0x7fffffff, 0x00020000);
        const unsigned avo = (unsigned)((t0 + r) * DM + w * 256 + 8 * q) * 2u, bvo = (unsigned)(r * DM + w * 256 + 8 * q) * 2u;
        u32x4 xa0[2], xa1[2], wh0[5], wh1[5];
#define P8_LOAD(XA, WH, s) do { _Pragma("unroll") for (int tl = 0; tl < 2; ++tl) XA[tl] = __builtin_amdgcn_raw_buffer_load_b128(hrs, avo, tl * 16 * DM * 2 + (s) * 64, 0); \
        _Pragma("unroll") for (int nb = 0; nb < 5; ++nb) WH[nb] = __builtin_amdgcn_raw_buffer_load_b128(wrs, bvo, nb * 16 * DM * 2 + (s) * 64, 0); } while (0)
#define P8_MMA(XA, WH) do { _Pragma("unroll") for (int tl = 0; tl < 2; ++tl) { const u32x4 hv = XA[tl]; \
            _Pragma("unroll") for (int c4 = 0; c4 < 4; ++c4) { const float lo_ = bf_lo(hv[c4]), hi_ = bf_hi(hv[c4]); ss[tl] += lo_ * lo_ + hi_ * hi_; } \
            const bf16x8 ah = *reinterpret_cast<const bf16x8*>(&hv); \
            _Pragma("unroll") for (int nb = 0; nb < 5; ++nb) acc[tl][nb] = __builtin_amdgcn_mfma_f32_16x16x32_bf16(ah, *reinterpret_cast<const bf16x8*>(&WH[nb]), acc[tl][nb], 0, 0, 0); } } while (0)
        P8_LOAD(xa0, wh0, 0);
        for (int s = 0; s < 8; s += 2) {
            P8_LOAD(xa1, wh1, s + 1); __builtin_amdgcn_sched_barrier(0);
            P8_MMA(xa0, wh0); __builtin_amdgcn_sched_barrier(0);
            if (s + 2 < 8) P8_LOAD(xa0, wh0, s + 2);
            __builtin_amdgcn_sched_barrier(0);
            P8_MMA(xa1, wh1); __builtin_amdgcn_sched_barrier(0);
        }
#undef P8_LOAD
#undef P8_MMA
#pragma unroll
        for (int tl = 0; tl < 2; ++tl) { ss[tl] += __shfl_xor(ss[tl], 16); ss[tl] += __shfl_xor(ss[tl], 32); }
        __syncthreads();
#pragma unroll
        for (int tl = 0; tl < 2; ++tl) {
#pragma unroll
            for (int nb = 0; nb < 5; ++nb)
#pragma unroll
                for (int reg = 0; reg < 4; ++reg) part[(w * 32 + tl * 16 + 4 * q + reg) * 80 + nb * 16 + r] = acc[tl][nb][reg];
            if (q == 0) pss[w * 32 + tl * 16 + r] = ss[tl]; }
        __syncthreads();
        if (F.tid < 32) { float s2 = 0.f;
#pragma unroll
            for (int k = 0; k < 8; ++k) s2 += pss[k * 32 + F.tid];
            prs[F.tid] = rsqrtf(s2 * (1.0f / DM) + 1e-6f); }
        __syncthreads();
        if (F.tid < 32) {
            const int t = blk * 32 + F.tid;
            const float rstd = prs[F.tid];
            float gl[8]; float gmax = -3.0e38f; int gi = 0;
#pragma unroll
            for (int j = 0; j < 8; ++j) { float a = 0.f;
#pragma unroll
                for (int k = 0; k < 8; ++k) a += part[(k * 32 + F.tid) * 80 + j];
                gl[j] = a * rstd + p.bg[j]; if (gl[j] > gmax) { gmax = gl[j]; gi = j; } }
            float den = 0.f;
#pragma unroll
            for (int j = 0; j < 8; ++j) den += __expf(gl[j] - gmax);
            const float gw = 1.0f / den;
            float v1 = -3.0e38f, v2 = -3.0e38f; int i1 = 0, i2 = 0;
            for (int j = 0; j < 8; ++j) { float a = 0.f; const int col = 8 + gi * 8 + j;
#pragma unroll
                for (int k = 0; k < 8; ++k) a += part[(k * 32 + F.tid) * 80 + col];
                const float el = a * rstd + p.be[gi * 8 + j];
                if (el > v1) { v2 = v1; i2 = i1; v1 = el; i1 = j; } else if (el > v2) { v2 = el; i2 = j; } }
            const float e2 = __expf(v2 - v1); const float w0 = gw / (1.0f + e2), w1 = gw * e2 / (1.0f + e2);
            const int e0 = gi * 8 + i1, e1 = gi * 8 + i2;
            const unsigned p0 = atomicAdd(&cnt[e0], 1u), p1 = atomicAdd(&cnt[e1], 1u);
            __hip_atomic_store(list + (size_t)e0 * SEQ + p0, t, __ATOMIC_RELAXED, __HIP_MEMORY_SCOPE_AGENT);
            __hip_atomic_store(list + (size_t)e1 * SEQ + p1, t, __ATOMIC_RELAXED, __HIP_MEMORY_SCOPE_AGENT);
            unsigned* ro = route + (size_t)t * 8; ro[0] = (unsigned)e0; ro[1] = (unsigned)e1; ro[2] = p0; ro[3] = p1; ro[4] = __float_as_uint(w0); ro[5] = __float_as_uint(w1);
        }
#pragma unroll 1
        for (int i0 = 0; i0 < 4; i0 += 2) {
            u32x2 hv[2][8];
#pragma unroll
            for (int i = 0; i < 2; ++i)
#pragma unroll
                for (int k = 0; k < 8; ++k) hv[i][k] = *(const u32x2*)(h1 + (size_t)(blk * 32 + w * 4 + i0 + i) * DM + (lane + 64 * k) * 4);
#pragma unroll
            for (int k = 0; k < 8; ++k) { const int c = (lane + 64 * k) * 4; const f32x4 g = *(const f32x4*)(p.norm_ffn_g + c);
#pragma unroll
                for (int i = 0; i < 2; ++i) { const int tl = w * 4 + i0 + i, t = blk * 32 + tl; const float rstd = prs[tl]; const u32x2 h = hv[i][k];
                    *(unsigned*)(fbf + (size_t)t * DM + c) = pk4_fp8(bf_lo(h.x) * rstd * g[0], bf_hi(h.x) * rstd * g[1], bf_lo(h.y) * rstd * g[2], bf_hi(h.y) * rstd * g[3]); } }
        }
    }
}

struct MoeTab { LAS int* eoff; LAS int* ord; };
__device__ __forceinline__ MoeTab moe_table(const Ctx& F, const bool compute) {
    MoeTab T; T.eoff = (LAS int*)(F.lds + LDS_MISC + 1024); T.ord = T.eoff + 80;
    if (!compute) return T;
    unsigned* cnt = (unsigned*)(F.ws + WS_CTL + CTL_CNT);
    __syncthreads();
    if (F.tid == 64) {
        unsigned* bw = (unsigned*)(F.ws + WS_CTL); int nx = 0, nloc = 1, xord = 0;
        for (int j = 0; j < 16; ++j) { const int c = (int)__hip_atomic_load(bw + XB_XCNT(j), __ATOMIC_RELAXED, __HIP_MEMORY_SCOPE_AGENT); if (c > 0) { ++nx; if (j < F.xcc) ++xord; } if (j == F.xcc) nloc = c; }
        if (nx < 1) nx = 1; if (nloc < 1) nloc = 1;
        T.eoff[144] = nx; T.eoff[145] = nloc; T.eoff[146] = xord; }
    if (F.tid < 64) {
        const int c = (int)__hip_atomic_load(cnt + F.tid, __ATOMIC_RELAXED, __HIP_MEMORY_SCOPE_AGENT); int s = c;
#pragma unroll
        for (int o = 1; o < 64; o <<= 1) { const int v = __shfl_up(s, o); if (F.tid >= o) s += v; }
        T.eoff[F.tid] = s - c; if (F.tid == 63) T.eoff[64] = s;
        int rank = 0;
        for (int k = 0; k < 64; ++k) { const int ck = __shfl(c, k); rank += (ck > c || (ck == c && k < F.tid)) ? 1 : 0; }
        T.ord[rank] = F.tid; }
    __syncthreads();
    return T;
}

template <int K, bool GU, int NACT>
__device__ __forceinline__ void moe_pass(const Ctx& F, const __amdgpu_buffer_rsrc_t wrs, const __amdgpu_buffer_rsrc_t ars, const unsigned wvo, const unsigned (&avo)[3][2], const unsigned wofs,
                                         const unsigned rbB, const unsigned ra, unsigned char* outp, int m0, int ne, int slab,
                                         const __amdgpu_buffer_rsrc_t wrs_n, const int pf_ld) {
    constexpr int NT = K / 64, NP = NT / 2, ldw = GU ? DEXP : DM, NA = NACT > 0 ? NACT : 1;
    constexpr float WSC = GU ? 64.0f : 32.0f;
    const int lane = F.lane, w = F.wave, r = lane & 15, kq = lane >> 4;
    LAS unsigned char* abase = F.lds + 16384 + w * 12288;
    const unsigned awo = (unsigned)((lane >> 3) * 128 + (((lane & 7) ^ ((lane >> 4) & 7)) * 16));
    f32x4 acc[NA][8];
#pragma unroll
    for (int j = 0; j < NA; ++j)
#pragma unroll
        for (int nb = 0; nb < 8; ++nb) acc[j][nb] = (f32x4){0.f, 0.f, 0.f, 0.f};
    f32x4 sB0[4], sB1[4]; u32x4 sA[NA][2]; unsigned pfv = 0;
#define MG_LOADB(S, t) do { _Pragma("unroll") for (int _j = 0; _j < 4; ++_j) { const u32x4 _v = __builtin_amdgcn_raw_buffer_load_b128(wrs, wvo, ((t) * 64 + _j) * ldw * 4, 0); S[_j] = *(const f32x4*)&_v; } } while (0)
#define MG_STOREB(S, buf) do { _Pragma("unroll") for (int _i = 0; _i < 4; ++_i) \
        *(LAS unsigned*)(F.lds + (buf) * 8192 + wofs + _i * 64) = pk4_fp8(S[0][_i] * WSC, S[1][_i] * WSC, S[2][_i] * WSC, S[3][_i] * WSC); } while (0)
#define MG_LOADA(pr) do { if (NACT > 0) { _Pragma("unroll") for (int _j = 0; _j < NA; ++_j) _Pragma("unroll") for (int _i = 0; _i < 2; ++_i) \
        sA[_j][_i] = __builtin_amdgcn_raw_buffer_load_b128(ars, avo[_j][_i], (pr) * 128, 0); } } while (0)
#define MG_STOREA(ao) do { if (NACT > 0) { _Pragma("unroll") for (int _j = 0; _j < NA; ++_j) _Pragma("unroll") for (int _i = 0; _i < 2; ++_i) \
        *(LAS u32x4*)(abase + (ao) + _j * 2048 + _i * 1024 + (awo ^ (_i * 64))) = sA[_j][_i]; } } while (0)
#define MG_COMPUTE(h, buf, ao) do { if (NACT > 0) { long _a[NA][2]; \
        _Pragma("unroll") for (int _j = 0; _j < NA; ++_j) { _a[_j][0] = *(const LAS long*)(abase + (ao) + _j * 2048 + (ra ^ (unsigned)((4 * (h)) * 16))); \
                                                             _a[_j][1] = *(const LAS long*)(abase + (ao) + _j * 2048 + (ra ^ (unsigned)((4 * (h) + 2) * 16))); } \
        _Pragma("unroll") for (int _nb = 0; _nb < 8; ++_nb) { \
        const long _b0 = *(const LAS long*)(F.lds + (buf) * 8192 + _nb * 1024 + rbB), _b1 = *(const LAS long*)(F.lds + (buf) * 8192 + _nb * 1024 + (rbB ^ 32u)); \
        _Pragma("unroll") for (int _j = 0; _j < NA; ++_j) { \
            acc[_j][_nb] = __builtin_amdgcn_mfma_f32_16x16x32_fp8_fp8(_b0, _a[_j][0], acc[_j][_nb], 0, 0, 0); \
            acc[_j][_nb] = __builtin_amdgcn_mfma_f32_16x16x32_fp8_fp8(_b1, _a[_j][1], acc[_j][_nb], 0, 0, 0); } \
        if ((_nb & 1) == 1) __builtin_amdgcn_sched_barrier(0); } } } while (0)
#define MG_SB __builtin_amdgcn_sched_barrier(0)
    MG_LOADB(sB0, 0); MG_LOADB(sB1, 1); MG_LOADA(0);
    __syncthreads();
    MG_STOREB(sB0, 0); MG_STOREA(0); MG_LOADA(1); MG_LOADB(sB0, 2);
    __syncthreads();
    int ap = 0;
    for (int P = 0; P + 2 < NP; ++P) {
        const int t = 2 * P;
        MG_STOREB(sB1, 1); MG_LOADB(sB1, t + 3); MG_SB; MG_COMPUTE(0, 0, ap); __syncthreads();
        MG_STOREB(sB0, 0); MG_STOREA(6144 - ap); MG_LOADA(P + 2); MG_LOADB(sB0, t + 4); MG_SB; MG_COMPUTE(1, 1, ap); __syncthreads();
        ap = 6144 - ap;
    }
    {
        MG_STOREB(sB1, 1); MG_LOADB(sB1, NT - 1); MG_SB; MG_COMPUTE(0, 0, ap); __syncthreads();
        MG_STOREB(sB0, 0); MG_STOREA(6144 - ap); MG_SB; MG_COMPUTE(1, 1, ap); __syncthreads();
        ap = 6144 - ap;
        if (pf_ld > 0) { const int t8 = F.tid & 255; pfv = __builtin_amdgcn_raw_buffer_load_b32(wrs_n, (unsigned)((((t8 >> 7) * 64 + ((t8 >> 1) & 63)) * pf_ld + (t8 & 1) * 32) * 4), 0, 0); }
        MG_STOREB(sB1, 1); MG_SB; MG_COMPUTE(0, 0, ap); __syncthreads();
        MG_COMPUTE(1, 1, ap); __syncthreads();
    }
#undef MG_SB
#undef MG_LOADB
#undef MG_STOREB
#undef MG_LOADA
#undef MG_STOREA
#undef MG_COMPUTE
    if (NACT > 0) {
#pragma unroll
        for (int j = 0; j < NA; ++j) { int m = m0 + 16 * (w + 8 * j) + r; asm volatile("" : "+v"(m));
            if (m < ne) {
                if (GU) {
                    unsigned d[4];
#pragma unroll
                    for (int nb = 0; nb < 4; ++nb) { const f32x4 g = acc[j][nb] * (1.0f / 64.0f), up = acc[j][nb + 4] * (8.0f / 64.0f);
                        d[nb] = pk4_fp8(fsilu(g[0]) * up[0], fsilu(g[1]) * up[1], fsilu(g[2]) * up[2], fsilu(g[3]) * up[3]); }
                    const auto s01 = __builtin_amdgcn_permlane16_swap(d[0], d[1], false, false), s23 = __builtin_amdgcn_permlane16_swap(d[2], d[3], false, false);
                    const auto t02 = __builtin_amdgcn_permlane32_swap(s01[0], s23[0], false, false), t13 = __builtin_amdgcn_permlane32_swap(s01[1], s23[1], false, false);
                    *(u32x4*)(outp + (size_t)m * DEXP + slab * 64 + 16 * kq) = (u32x4){t02[0], t13[0], t02[1], t13[1]}; }
                else {
                    bf16_t* dst = (bf16_t*)outp + (size_t)m * DM + slab * 128 + 16 * (kq & 1) + 8 * (kq >> 1);
#pragma unroll
                    for (int nb = 0; nb < 8; nb += 2) { const f32x4 v0 = acc[j][nb] * (1.0f / 256.0f), v1 = acc[j][nb + 1] * (1.0f / 256.0f);
                        const auto rx = __builtin_amdgcn_permlane16_swap(cvt_pk_bf16(v0[0], v0[1]), cvt_pk_bf16(v1[0], v1[1]), false, false);
                        const auto ry = __builtin_amdgcn_permlane16_swap(cvt_pk_bf16(v0[2], v0[3]), cvt_pk_bf16(v1[2], v1[3]), false, false);
                        *(u32x4*)(dst + 16 * nb) = (u32x4){rx[0], ry[0], rx[1], ry[1]}; } }
            } }
    }    asm volatile("" :: "v"(pfv));
}
template <int K, bool GU>
__device__ __forceinline__ void moe_gemm(const Params& p, const Ctx& F, const MoeTab& T) {
    const int tid = F.tid, lane = F.lane, w = F.wave, r = lane & 15, kq = lane >> 4;
    const int kg = (tid >> 4) & 15, ng = (tid & 15) + 16 * (tid >> 8);
    const unsigned char* fbf = (const unsigned char*)(F.ws + WS_FBF); unsigned char* hb = (unsigned char*)(F.ws + WS_HB); bf16_t* yb = (bf16_t*)(F.ws + WS_YB);
    const int* list = (const int*)(F.ws + WS_LIST);
    const unsigned wofs = (unsigned)((4 * ng) * 64 + (((kg >> 2) ^ (ng & 3)) * 16) + (kg & 3) * 4);
    const unsigned rbB = (unsigned)(r * 64 + (((kq >> 1) ^ ((r >> 2) & 3)) * 16) + (kq & 1) * 8);
    const unsigned ra = (unsigned)(r * 128 + (((kq >> 1) ^ ((r >> 1) & 7)) * 16) + (kq & 1) * 8);
    constexpr int ldw = GU ? DEXP : DM;
    const unsigned wvo = (unsigned)((4 * kg) * ldw + 4 * (tid & 15)) * 4u;
    const int nx = T.eoff[144], nloc = T.eoff[145], xord = T.eoff[146];
    const int nexp_x = (NEXP - xord + nx - 1) / nx;
    auto unit_rsrc = [&](bool dn, int e, int slab) -> __amdgpu_buffer_rsrc_t {
        const char* wbase;
        if (!dn) wbase = (const char*)((w < 4 ? p.w_gate : p.w_up) + (size_t)e * DM * DEXP + slab * 64);
        else wbase = (const char*)(p.w_down + (size_t)e * DEXP * DM + slab * 128 + (w < 4 ? 0 : 64));
        const unsigned long long wb = (unsigned long long)wbase; const unsigned lo = __builtin_amdgcn_readfirstlane((unsigned)wb), hi = __builtin_amdgcn_readfirstlane((unsigned)(wb >> 32));
        wbase = (const char*)(((unsigned long long)hi << 32) | lo);
        return __builtin_amdgcn_make_buffer_rsrc((void*)wbase, 0, 0x7fffffff, 0x00020000); };
    const int gpx = nloc >> 4, ngr = nx * gpx; const bool bal = (nloc & 15) == 0 && gpx > 0 && (NEXP % ngr) == 0;
    const int per = bal ? NEXP / ngr : 0, grp = xord * gpx + (F.xrank >> 4);
    auto unit_at = [&](int i) -> int {
        if (bal) { if (i >= per) return -1; return (T.ord[i * ngr + ((i & 1) ? ngr - 1 - grp : grp)] << 4) | (F.xrank & 15); }
        const int q = F.xrank + i * nloc; if (q >= nexp_x * 16) return -1; return ((xord + (q >> 4) * nx) << 4) | (q & 15); };
    for (int i = 0; ; ++i) {
        const int ue = unit_at(i); if (ue < 0) break;
        const int e = ue >> 4, slab = ue & 15;
        const int e0 = T.eoff[e], ne = T.eoff[e + 1] - e0;
        const __amdgpu_buffer_rsrc_t wrs = unit_rsrc(!GU, e, slab);
        const int un = unit_at(i + 1); const bool haven = un >= 0; const int u0 = unit_at(0);
        const int en = haven ? un >> 4 : u0 >> 4, slabn = haven ? (un & 15) : (u0 & 15);
        const bool nextdn = haven ? !GU : true;
        const __amdgpu_buffer_rsrc_t wrsn = unit_rsrc(nextdn, en, slabn);
        const int ldn = (haven || GU) ? (nextdn ? DM : DEXP) : 0;
        const char* abase = GU ? (const char*)fbf : (const char*)(hb + (size_t)e0 * DEXP);
        { const unsigned long long ab = (unsigned long long)abase; const unsigned lo = __builtin_amdgcn_readfirstlane((unsigned)ab), hi = __builtin_amdgcn_readfirstlane((unsigned)(ab >> 32));
          abase = (const char*)(((unsigned long long)hi << 32) | lo); }
        const __amdgpu_buffer_rsrc_t ars = __builtin_amdgcn_make_buffer_rsrc((void*)abase, 0, 0x7fffffff, 0x00020000);
        unsigned char* outp = GU ? hb + (size_t)e0 * DEXP : (unsigned char*)(yb + (size_t)e0 * DM);
        for (int m0 = 0; m0 < ne; m0 += 384) {
            unsigned avo[3][2];
#pragma unroll
            for (int j = 0; j < 3; ++j)
#pragma unroll
                for (int i2 = 0; i2 < 2; ++i2) { int m = m0 + 16 * (w + 8 * j) + (lane >> 3) + 8 * i2; const bool past = m >= ne; if (past) m = ne - 1;
                    if (GU) { const int tok = list[(size_t)e * SEQ + m]; avo[j][i2] = (unsigned)tok * (unsigned)DM + 16u * (lane & 7); }
                    else avo[j][i2] = (unsigned)m * (unsigned)DEXP + 16u * (lane & 7);
                    if (past) avo[j][i2] = 0x80000000u; }
            int nact = 0;
#pragma unroll
            for (int j = 0; j < 3; ++j) if (m0 + 16 * (w + 8 * j) < ne) nact = j + 1;
            const bool lastp = m0 + 384 >= ne;
            if (nact == 3) moe_pass<K, GU, 3>(F, wrs, ars, wvo, avo, wofs, rbB, ra, outp, m0, ne, slab, lastp ? wrsn : wrs, lastp ? ldn : ldw);
            else if (nact == 2) moe_pass<K, GU, 2>(F, wrs, ars, wvo, avo, wofs, rbB, ra, outp, m0, ne, slab, lastp ? wrsn : wrs, lastp ? ldn : ldw);
            else if (nact == 1) moe_pass<K, GU, 1>(F, wrs, ars, wvo, avo, wofs, rbB, ra, outp, m0, ne, slab, lastp ? wrsn : wrs, lastp ? ldn : ldw);
            else moe_pass<K, GU, 0>(F, wrs, ars, wvo, avo, wofs, rbB, ra, outp, m0, ne, slab, lastp ? wrsn : wrs, lastp ? ldn : ldw);
        }
    }
}

__device__ __forceinline__ void p11_final(const Params& p, const Ctx& F) {
    const bf16_t* h1 = (const bf16_t*)(F.ws + WS_H1); const bf16_t* yb = (const bf16_t*)(F.ws + WS_YB); const unsigned* route = (const unsigned*)(F.ws + WS_ROUTE);
    const MoeTab T = moe_table(F, MK_TABLE_EVERY_PHASE);
    const int gw = F.bid * 8 + F.wave, nw = F.G * 8, lane = F.lane;
    u32x4 rA = (u32x4){0u, 0u, 0u, 0u}; u32x2 rB = (u32x2){0u, 0u};
    if (gw < SEQ) { rA = *(const u32x4*)(route + (size_t)gw * 8); rB = *(const u32x2*)(route + (size_t)gw * 8 + 4); }
    for (int t = gw; t < SEQ; t += nw) {
        const u32x4 cA = rA; const u32x2 cB = rB;
        if (t + nw < SEQ) { rA = *(const u32x4*)(route + (size_t)(t + nw) * 8); rB = *(const u32x2*)(route + (size_t)(t + nw) * 8 + 4); }
        const int e0 = (int)cA[0], e1 = (int)cA[1]; const size_t s0 = (size_t)T.eoff[e0] + cA[2], s1 = (size_t)T.eoff[e1] + cA[3];
        const float w0 = __uint_as_float(cB[0]), w1 = __uint_as_float(cB[1]);
        f32x4 v[8]; float ss = 0.f;
#pragma unroll
        for (int i = 0; i < 8; ++i) { const int c = (lane + 64 * i) * 4; { const u32x2 hh = *(const u32x2*)(h1 + (size_t)t * DM + c); v[i] = (f32x4){bf_lo(hh.x), bf_hi(hh.x), bf_lo(hh.y), bf_hi(hh.y)}; }
            const u32x2 a = *(const u32x2*)(yb + s0 * DM + c), b = *(const u32x2*)(yb + s1 * DM + c);
            v[i][0] += w0 * bf_lo(a.x) + w1 * bf_lo(b.x); v[i][1] += w0 * bf_hi(a.x) + w1 * bf_hi(b.x); v[i][2] += w0 * bf_lo(a.y) + w1 * bf_lo(b.y); v[i][3] += w0 * bf_hi(a.y) + w1 * bf_hi(b.y);
            ss += v[i][0] * v[i][0] + v[i][1] * v[i][1] + v[i][2] * v[i][2] + v[i][3] * v[i][3]; }
        ss = wave_sum(ss); const float rstd = rsqrtf(ss * (1.0f / DM) + 1e-6f);
#pragma unroll
        for (int i = 0; i < 8; ++i) { const int c = (lane + 64 * i) * 4; const f32x4 g = *(const f32x4*)(p.norm_final_g + c);
            *(f32x4*)(p.out + (size_t)t * DM + c) = (f32x4){v[i][0] * rstd * g[0], v[i][1] * rstd * g[1], v[i][2] * rstd * g[2], v[i][3] * rstd * g[3]}; }
    }
}

constexpr int N_PHASES = 12;
__global__ void __launch_bounds__(NTHREADS, 2) mk_fwd(Params p) {
    extern __shared__ __attribute__((aligned(16))) unsigned char lds_raw[];
    Ctx F; F.lds = (LAS unsigned char*)lds_raw; F.tid = threadIdx.x; F.lane = F.tid & 63; F.wave = __builtin_amdgcn_readfirstlane(F.tid >> 6); F.G = gridDim.x; F.bid = blockIdx.x; F.ws = p.ws;
    volatile LAS unsigned* misc = (volatile LAS unsigned*)(F.lds + LDS_MISC);
    if (F.tid < 4) misc[F.tid] = 0u;
    if (F.tid == 0) { const unsigned x = xb_xcc_id(); misc[4] = x; misc[5] = xb_add((unsigned*)(F.ws + WS_CTL + CTL_XRANK) + 64 * x, 1u); }
    __syncthreads();
    F.xcc = (int)misc[4]; F.xrank = (int)misc[5];
    const int lo = p.ph_lo, hi = p.ph_hi;
    XcdBarrier bar; bar.bar = (unsigned*)(F.ws + WS_CTL); bar.x = 0; bar.st = misc;
    if (hi - lo > 1) bar = xcd_barrier_post((unsigned*)(F.ws + WS_CTL), misc);
#ifdef ONLY_PHASE
#define IN(k) ((k) == ONLY_PHASE && lo <= (k) && (k) < hi)
#else
#define IN(k) (lo <= (k) && (k) < hi)
#endif
#define SEAM(k) do { if (IN(k) && IN((k) + 1)) xcd_barrier(bar); } while (0)
#ifndef PROBE_REP_MASK
#define PROBE_REP_MASK 0
#endif
#define RUN(k, ...) do { if (IN(k)) { __VA_ARGS__; if ((PROBE_REP_MASK >> (k)) & 1) { xcd_barrier(bar); __VA_ARGS__; } } SEAM(k); } while (0)
    RUN(0, p0_prologue(p, F));
    RUN(1, { pg8::StaticOrder S; S.init(MROWS, INW, DM, F.ws + WS_WIN, F.G, F.bid); pg8::EpiBf16 E{(bf16_t*)(F.ws + WS_PROJ), INW};
        pg8::gemm_phase<DM>(F.lds, (const char*)(F.ws + WS_ABF), S, E); p1_side_jobs(p, F, (MROWS / 256) * (INW / 256)); });
    RUN(2, p2_post(p, F));
    RUN(3, p3_ret_state(p, F));
    RUN(4, p4_ret_scan(p, F));
    RUN(5, { p5_ret_out(p, F); __syncthreads(); p5_attention(p, F); });
    RUN(7, { pg8::StaticOrder S; S.init(SEQ, DM, DM, F.ws + WS_WOUT, F.G, F.bid); pg8::EpiBf16ResMid E{(bf16_t*)(F.ws + WS_H1), p.x, DM, (const float*)(F.ws + WS_ATTO), (LAS float*)(F.lds + LDS_MISC + 4096)};
        pg8::gemm_phase<DM>(F.lds, (const char*)(F.ws + WS_MIXA), S, E); });
    RUN(8, p8_router(p, F));
    RUN(9, { const MoeTab T = moe_table(F, true); moe_gemm<DM, true>(p, F, T); });
    RUN(10, { const MoeTab T = moe_table(F, MK_TABLE_EVERY_PHASE); moe_gemm<DEXP, false>(p, F, T); });
    RUN(11, p11_final(p, F));
#undef RUN
#undef IN
#undef SEAM
}

extern "C" void kernel_launch(void* const* d_in, const int* in_sizes, int n_in, void* d_out, int out_size, void* d_ws, size_t ws_size, hipStream_t stream) {
    static int grid = 0;
    if (grid == 0) {
        if (n_in != 20 || out_size != SEQ * DM || ws_size < WS_END) { fprintf(stderr, "kernel_launch: unexpected shapes: n_in %d out %d ws %zu (need %zu)\n", n_in, out_size, ws_size, (size_t)WS_END); grid = -1; return; }
        int dev = 0, cus = 0, per_cu = 0;
        if (hipGetDevice(&dev) != hipSuccess || hipDeviceGetAttribute(&cus, hipDeviceAttributeMultiprocessorCount, dev) != hipSuccess) { grid = -1; return; }
        if (hipFuncSetAttribute((const void*)mk_fwd, hipFuncAttributeMaxDynamicSharedMemorySize, LDS_BYTES) != hipSuccess) { fprintf(stderr, "kernel_launch: hipFuncSetAttribute failed\n"); grid = -1; return; }
        if (hipOccupancyMaxActiveBlocksPerMultiprocessor(&per_cu, (const void*)mk_fwd, NTHREADS, LDS_BYTES) != hipSuccess || per_cu < 1) { fprintf(stderr, "kernel_launch: occupancy query says %d\n", per_cu); }
        (void)hipGetLastError();
        grid = cus;
    }
    if (grid < 0) return;
    (void)hipMemsetAsync((char*)d_ws + WS_CTL, 0, CTL_BYTES, stream);
    Params p{};
    p.x = (const float*)d_in[0]; p.meta = (const float*)d_in[1]; p.norm_mix_g = (const float*)d_in[2]; p.w_in = (const float*)d_in[3]; p.lf = (const float*)d_in[4]; p.lb = (const float*)d_in[5];
    p.ret_norm_g = (const float*)d_in[6]; p.gq = (const float*)d_in[7]; p.gk = (const float*)d_in[8]; p.attn_out_g = (const float*)d_in[9]; p.w_out = (const float*)d_in[10]; p.norm_ffn_g = (const float*)d_in[11];
    p.wg = (const float*)d_in[12]; p.bg = (const float*)d_in[13]; p.we = (const float*)d_in[14]; p.be = (const float*)d_in[15]; p.w_gate = (const float*)d_in[16]; p.w_up = (const float*)d_in[17]; p.w_down = (const float*)d_in[18];
    p.norm_final_g = (const float*)d_in[19]; p.out = (float*)d_out; p.ws = (unsigned char*)d_ws;
#if MK_N_LAUNCHES == 1
    p.ph_lo = 0; p.ph_hi = N_PHASES;
    hipLaunchKernelGGL(mk_fwd, dim3(grid), dim3(NTHREADS), LDS_BYTES, stream, p);
#else
    for (int k = 0; k < N_PHASES; ++k) { p.ph_lo = k; p.ph_hi = k + 1; hipLaunchKernelGGL(mk_fwd, dim3(grid), dim3(NTHREADS), LDS_BYTES, stream, p); }
#endif
    const hipError_t le = hipPeekAtLastError();
    if (le != hipSuccess) fprintf(stderr, "kernel_launch: launch failed: %s\n", hipGetErrorName(le));
}
```

```cpp
#include <hip/hip_runtime.h>
#include <cstdio>
#include <cstdint>

#ifndef MK_N_LAUNCHES
#define MK_N_LAUNCHES 1
#endif

#if MK_N_LAUNCHES == 1 && !defined(ONLY_PHASE)
#define MK_TABLE_EVERY_PHASE false
#else
#define MK_TABLE_EVERY_PHASE true
#endif
#define LAS __attribute__((address_space(3)))
typedef unsigned short bf16_t;
typedef short bf16x8 __attribute__((ext_vector_type(8)));
typedef short s16x4 __attribute__((ext_vector_type(4)));
typedef float f32x4 __attribute__((ext_vector_type(4)));
typedef float f32x2 __attribute__((ext_vector_type(2)));
typedef float f32x16 __attribute__((ext_vector_type(16)));
typedef float f32x8 __attribute__((ext_vector_type(8)));
typedef unsigned u32x4 __attribute__((ext_vector_type(4)));
typedef unsigned u32x2 __attribute__((ext_vector_type(2)));

constexpr int DM = 2048, SEQ = 8192, NMETA = 16, PREFIX = 128, PADN = 112, LP = SEQ + PREFIX  , MROWS = 8448  ;
constexpr int INW = 4608, NEXP = 64, DEXP = 1024;
constexpr int C_RQ = 0, C_RK = 512, C_RV = 1024, C_RG = 2048, C_AQ = 3072, C_AK = 4096, C_AV = 4352;
constexpr int NKEY = 8320;
constexpr int NCHUNK = 65;
constexpr int NTHREADS = 512;
constexpr int LDS_BYTES = 147456;
constexpr int LDS_MISC = 131072;

constexpr size_t al256(size_t x) { return (x + 255) / 256 * 256; }
constexpr size_t WS_CTL = 0;
constexpr size_t CTL_BYTES = 65536;
constexpr size_t CTL_CNT = 16384;
constexpr size_t CTL_XRANK = 20480;
constexpr size_t WS_TABQ = WS_CTL + CTL_BYTES;
constexpr size_t WS_TABR = WS_TABQ + 128 * 32 * 8;
constexpr size_t WS_WR = al256(WS_TABR + 128 * 16 * 8);
constexpr size_t WS_ABF = al256(WS_WR + (size_t)DM * 80 * 4);
constexpr size_t WS_WIN = al256(WS_ABF + (size_t)MROWS * DM * 2);
constexpr size_t WS_WOUT = al256(WS_WIN + (size_t)INW * DM * 2);
constexpr size_t WS_PROJ = al256(WS_WOUT + (size_t)DM * DM * 2);
constexpr size_t WS_RQ = al256(WS_PROJ + (size_t)MROWS * INW * 2);
constexpr size_t WS_RK = al256(WS_RQ + (size_t)MROWS * 512 * 2);
constexpr size_t WS_AQ = al256(WS_RK + (size_t)MROWS * 512 * 2);
constexpr size_t WS_AK = al256(WS_AQ + (size_t)SEQ * 1024 * 2);
constexpr size_t WS_AV = al256(WS_AK + (size_t)NKEY * 256 * 2);
constexpr size_t WS_UST = al256(WS_AV + (size_t)NKEY * 256 * 2);
constexpr size_t WS_SST = al256(WS_UST + (size_t)NCHUNK * 8 * 2 * 8192 * 4);
constexpr size_t WS_ATTO = al256(WS_SST + (size_t)NCHUNK * 8 * 2 * 8192 * 2);
constexpr size_t WS_MIXA = al256(WS_ATTO + (size_t)SEQ * 1024 * 4);
constexpr size_t WS_H1 = al256(WS_MIXA + (size_t)SEQ * DM * 2);
constexpr size_t WS_FBF = al256(WS_H1 + (size_t)SEQ * DM * 4);
constexpr size_t WS_ROUTE = al256(WS_FBF + (size_t)SEQ * DM * 2);
constexpr size_t WS_LIST = al256(WS_ROUTE + (size_t)SEQ * 32);
constexpr size_t WS_HB = al256(WS_LIST + (size_t)NEXP * SEQ * 4);
constexpr size_t WS_YB = al256(WS_HB + (size_t)16384 * 1024 * 2);
constexpr size_t WS_END = al256(WS_YB + (size_t)16384 * 2048 * 2);

struct Params {
    const float* x; const float* meta; const float* norm_mix_g; const float* w_in; const float* lf; const float* lb;
    const float* ret_norm_g; const float* gq; const float* gk; const float* attn_out_g; const float* w_out; const float* norm_ffn_g;
    const float* wg; const float* bg; const float* we; const float* be; const float* w_gate; const float* w_up; const float* w_down;
    const float* norm_final_g; float* out; unsigned char* ws; int ph_lo, ph_hi;
};

#define XB_TMO      128
#define XB_XCNT(j)  (256  + 64 * (j))
#define XB_XSUB(j)  (1280 + 64 * (j))
#define XB_XGEN(j)  (2304 + 64 * (j))
#define XB_TOP      3328
#define XB_TOPGEN   3392
#define XCD_BAR_WORDS 3456
#define XB_SPIN_CAP (1u << 18)

__device__ __forceinline__ unsigned xb_ld(unsigned* p)              { return __hip_atomic_load(p, __ATOMIC_RELAXED, __HIP_MEMORY_SCOPE_AGENT); }
__device__ __forceinline__ unsigned xb_add(unsigned* p, unsigned v) { return __hip_atomic_fetch_add(p, v, __ATOMIC_RELAXED, __HIP_MEMORY_SCOPE_AGENT); }
__device__ __forceinline__ unsigned xb_xcc_id() { return (unsigned)__builtin_amdgcn_s_getreg((3 << 11) | 20) & 0xFu; }
#define XB_SPIN(cond, bar) do { unsigned _sp = 0; while (cond) { __builtin_amdgcn_s_sleep(1); \
    if ((++_sp & 255u) == 0u) { if (xb_ld(&(bar)[XB_TMO])) break; if (_sp > XB_SPIN_CAP) { atomicAdd(&(bar)[XB_TMO], 1u); break; } } } } while (0)

struct XcdBarrier { unsigned* bar; unsigned x; volatile LAS unsigned* st; };

__device__ __forceinline__ XcdBarrier xcd_barrier_post(unsigned* bar, volatile LAS unsigned* st) {
    XcdBarrier b; b.bar = bar; b.x = xb_xcc_id(); b.st = st;
    if (threadIdx.x == 0) (void)xb_add(&bar[XB_XCNT(b.x)], 1u);
    return b;
}
__device__ __forceinline__ void xcd_barrier_complete(unsigned* bar, unsigned x, unsigned& nloc, unsigned& nx) {
    const unsigned G = gridDim.x * gridDim.y * gridDim.z;
    unsigned sum, cnt, mine, sp = 0u;
    for (;;) {
        sum = 0u; cnt = 0u; mine = 0u;
#pragma unroll
        for (unsigned j = 0; j < 16; ++j) { const unsigned c = xb_ld(&bar[XB_XCNT(j)]); sum += c; cnt += (c > 0u) ? 1u : 0u; mine = (j == x) ? c : mine; }
        if (sum == G) break;
        __builtin_amdgcn_s_sleep(1);
        if ((++sp & 255u) == 0u) { if (xb_ld(&bar[XB_TMO])) break; if (sp > XB_SPIN_CAP) { atomicAdd(&bar[XB_TMO], 1u); break; } }
    }
    nloc = mine > 0u ? mine : 1u; nx = cnt > 0u ? cnt : 1u;
}
__device__ __forceinline__ void xcd_barrier(const XcdBarrier& b) {
    asm volatile("s_waitcnt vmcnt(0)" ::: "memory");
    __syncthreads();
    if (threadIdx.x == 0) {
        unsigned* bar = b.bar;
        __builtin_amdgcn_s_waitcnt(0);
        unsigned nloc = b.st[0], nx = b.st[1];
        if (nloc == 0u) { xcd_barrier_complete(bar, b.x, nloc, nx); b.st[0] = nloc; b.st[1] = nx; }
        const unsigned old = xb_add(&bar[XB_XSUB(b.x)], 1u);
        const unsigned gen = old / nloc;
        if (old + 1u == (gen + 1u) * nloc) {
            __builtin_amdgcn_fence(__ATOMIC_RELEASE, "agent");
            asm volatile("s_waitcnt vmcnt(0)" ::: "memory");
            const unsigned og = xb_add(&bar[XB_TOP], 1u);
            const unsigned tg = og / nx;
            if (og + 1u == (tg + 1u) * nx) xb_add(&bar[XB_TOPGEN], 1u);
            else XB_SPIN(xb_ld(&bar[XB_TOPGEN]) == tg, bar);
            __builtin_amdgcn_fence(__ATOMIC_ACQUIRE, "agent");
            xb_add(&bar[XB_XGEN(b.x)], 1u);
            asm volatile("s_waitcnt vmcnt(0)" ::: "memory");
        } else {
            XB_SPIN(xb_ld(&bar[XB_XGEN(b.x)]) == gen, bar);
            __builtin_amdgcn_fence(__ATOMIC_ACQUIRE, "agent");
            asm volatile("s_waitcnt vmcnt(0)" ::: "memory");
        }
    }
    __syncthreads();
}

__device__ __forceinline__ unsigned cvt_pk_bf16(float lo, float hi) { unsigned r; asm volatile("v_cvt_pk_bf16_f32 %0, %1, %2" : "=v"(r) : "v"(lo), "v"(hi)); return r; }
__device__ __forceinline__ unsigned pk4_fp8(float a, float b, float c, float d) { int v = __builtin_amdgcn_cvt_pk_fp8_f32(a, b, 0, false); v = __builtin_amdgcn_cvt_pk_fp8_f32(c, d, v, true); return (unsigned)v; }
__device__ __forceinline__ float bf_lo(unsigned w) { return __uint_as_float(w << 16); }
__device__ __forceinline__ float bf_hi(unsigned w) { return __uint_as_float(w & 0xffff0000u); }
__device__ __forceinline__ float bf2f(bf16_t b) { return __uint_as_float(((unsigned)b) << 16); }
__device__ __forceinline__ float wave_sum(float v) {
#pragma unroll
    for (int o = 32; o >= 1; o >>= 1) v += __shfl_xor(v, o);
    return v;
}
__device__ __forceinline__ float fsilu(float v) { return v / (1.0f + __expf(-v)); }
__device__ __forceinline__ bf16x8 tr_frag(LAS unsigned char* lanebase, int stride, int k0, int c0) {
    LAS unsigned char* a = lanebase + k0 * stride + c0 * 2;
    const s16x4 lo = __builtin_amdgcn_ds_read_tr16_b64_v4i16((LAS s16x4*)a), hi = __builtin_amdgcn_ds_read_tr16_b64_v4i16((LAS s16x4*)(a + 16 * stride));
    return (bf16x8){lo[0], lo[1], lo[2], lo[3], hi[0], hi[1], hi[2], hi[3]};
}
__device__ __forceinline__ int tr_lane_off(int lane, int stride) { const int i = lane & 15, g = lane >> 4; return (4 * g + (i >> 2)) * stride + (i & 3) * 8; }

namespace pg8 {
constexpr int BM = 256, BK = 64, HALF = 128, HTB = HALF * BK * 2, STAGE_BYTES = 8 * HTB, NXCD = 8, WGM = 8;
__host__ __device__ __forceinline__ int lds_byte(int r, int c) { const int st = (r >> 4) * 2 + (c >> 5), rr = r & 15, cc = c & 31, ob = rr * 64 + cc * 2; return st * 1024 + (ob ^ (((ob >> 9) & 1) << 5)); }
__host__ __device__ __forceinline__ void stage_rc(int b, int& R, int& C) { const int st = b / 1024, sb = b % 1024, swz = sb ^ (((sb >> 9) & 1) << 5); R = (st >> 1) * 16 + swz / 64; C = (st & 1) * 32 + (swz % 64) / 2; }
__host__ __device__ __forceinline__ int perm32(int rho) { const int n = rho >> 4, i = rho & 15; return 8 * (i >> 2) + 4 * n + (i & 3); }

struct Unit { int pm, pn; const char* B; int aux; };

struct StaticOrder {
    int nM, nN, nwg, G, c, K; const char* Bt;
    __device__ void init(int M, int N, int K_, const void* Bt_, int G_, int c_) { nM = M / BM; nN = N / BM; nwg = nM * nN; G = G_; c = c_; K = K_; Bt = (const char*)Bt_; }
    __device__ __forceinline__ bool next(int i, Unit& u) const {
        const long L = (long)i * G + c; if (L >= nwg) return false;
        int wgid = (int)L; { const int q = nwg / NXCD, r = nwg % NXCD, xcd = wgid % NXCD, off = wgid / NXCD; wgid = (xcd < r ? xcd * (q + 1) : r * (q + 1) + (xcd - r) * q) + off; }
        const int nig = WGM * nN, gid = wgid / nig, fm = gid * WGM, gsz = (nM - fm) < WGM ? (nM - fm) : WGM;
        u.pm = fm + ((wgid % nig) % gsz); u.pn = (wgid % nig) / gsz; u.B = Bt + (size_t)u.pn * BM * K * 2; u.aux = 0; return true;
    }
    __device__ __forceinline__ unsigned a_row_off(const Unit& u, int row) const { return (unsigned)(u.pm * BM + row) * (unsigned)(K * 2); }
};

struct EpiBf16 {
    static constexpr bool MID = false; static constexpr bool PERM = true;
    bf16_t* O; int ldc;
    __device__ __forceinline__ void operator()(const f32x4 (&acc)[2][2][4][2], const Unit& u, int wr, int wc, int fr, int fq) const {
        const int row0 = u.pm * BM + wr * 64 + fr; const int col0 = u.pn * BM + wc * 32 + 8 * fq;
#pragma unroll
        for (int ai = 0; ai < 2; ++ai)
#pragma unroll
            for (int m = 0; m < 4; ++m) { bf16_t* rowp = O + (size_t)(row0 + ai * HALF + m * 16) * ldc + col0;
#pragma unroll
                for (int bj = 0; bj < 2; ++bj) { const f32x4 v0 = acc[ai][bj][m][0], v1 = acc[ai][bj][m][1];
                    u32x4 w; w.x = cvt_pk_bf16(v0[0], v0[1]); w.y = cvt_pk_bf16(v0[2], v0[3]); w.z = cvt_pk_bf16(v1[0], v1[1]); w.w = cvt_pk_bf16(v1[2], v1[3]);
                    *(u32x4*)(rowp + bj * HALF) = w; } }
    }
};
struct EpiBf16Res {
    static constexpr bool MID = false; static constexpr bool PERM = true;
    bf16_t* O; const float* base; int ldc;
    __device__ __forceinline__ void operator()(const f32x4 (&acc)[2][2][4][2], const Unit& u, int wr, int wc, int fr, int fq) const {
        const int row0 = u.pm * BM + wr * 64 + fr; const int col0 = u.pn * BM + wc * 32 + 8 * fq;
#pragma unroll
        for (int ai = 0; ai < 2; ++ai)
#pragma unroll
            for (int m = 0; m < 4; ++m) { const size_t off = (size_t)(row0 + ai * HALF + m * 16) * ldc + col0;
#pragma unroll
                for (int bj = 0; bj < 2; ++bj) { const f32x4 v0 = acc[ai][bj][m][0] + *(const f32x4*)(base + off + bj * HALF), v1 = acc[ai][bj][m][1] + *(const f32x4*)(base + off + bj * HALF + 4);
                    u32x4 w; w.x = cvt_pk_bf16(v0[0], v0[1]); w.y = cvt_pk_bf16(v0[2], v0[3]); w.z = cvt_pk_bf16(v1[0], v1[1]); w.w = cvt_pk_bf16(v1[2], v1[3]);
                    *(u32x4*)(O + off + bj * HALF) = w; } }
    }
};
struct EpiBf16ResMid {
    static constexpr bool MID = true; static constexpr bool PERM = true;
    bf16_t* O; const float* base; int ldc; const float* ssq; LAS float* rs;
    __device__ __forceinline__ void begin_unit(const Unit& u, int tid) const {
        if (tid < BM) { const float* s = ssq + (size_t)(u.pm * BM + tid) * 16; const f32x4 s0 = *(const f32x4*)(s), s1 = *(const f32x4*)(s + 4), s2 = *(const f32x4*)(s + 8), s3 = *(const f32x4*)(s + 12);
            const float ss = ((s0[0] + s0[1]) + (s0[2] + s0[3])) + ((s1[0] + s1[1]) + (s1[2] + s1[3])) + ((s2[0] + s2[1]) + (s2[2] + s2[3])) + ((s3[0] + s3[1]) + (s3[2] + s3[3]));
            rs[tid] = rsqrtf(ss * (1.0f / 1024.0f) + 1e-6f); }
        asm volatile("s_waitcnt lgkmcnt(0)" ::: "memory");
    }
    __device__ __forceinline__ void warm(const Unit& u, int tid, LAS unsigned char* dump) const {
        int tt = tid; asm volatile("" : "+v"(tt));
        LAS unsigned* d = (LAS unsigned*)(dump + (tt >> 6) * 256);
#pragma unroll
        for (int i = 0; i < 4; ++i) { const int L = tt + 512 * i;
            __builtin_amdgcn_global_load_lds((const unsigned*)(base + (size_t)(u.pm * BM + (L >> 3)) * ldc + u.pn * BM + (L & 7) * 32), d, 4, 0, 0); }
    }
    __device__ __forceinline__ void mid(f32x4 (&acc)[2][2][4][2], int wr, int fr) const {
#pragma unroll
        for (int ai = 0; ai < 2; ++ai)
#pragma unroll
            for (int m = 0; m < 4; ++m) { const float s = rs[ai * HALF + wr * 64 + m * 16 + fr];
#pragma unroll
                for (int bj = 0; bj < 2; ++bj)
#pragma unroll
                    for (int n = 0; n < 2; ++n) acc[ai][bj][m][n] = acc[ai][bj][m][n] * s; }
    }
    __device__ __forceinline__ void operator()(const f32x4 (&acc)[2][2][4][2], const Unit& u, int wr, int wc, int fr, int fq) const {
        const int row0 = u.pm * BM + wr * 64 + fr; const int col0 = u.pn * BM + wc * 32 + 8 * fq;
#pragma unroll
        for (int ai = 0; ai < 2; ++ai)
#pragma unroll
            for (int m = 0; m < 4; ++m) { const size_t off = (size_t)(row0 + ai * HALF + m * 16) * ldc + col0;
#pragma unroll
                for (int bj = 0; bj < 2; ++bj) { const f32x4 v0 = acc[ai][bj][m][0] + *(const f32x4*)(base + off + bj * HALF), v1 = acc[ai][bj][m][1] + *(const f32x4*)(base + off + bj * HALF + 4);
                    u32x4 w; w.x = cvt_pk_bf16(v0[0], v0[1]); w.y = cvt_pk_bf16(v0[2], v0[3]); w.z = cvt_pk_bf16(v1[0], v1[1]); w.w = cvt_pk_bf16(v1[2], v1[3]);
                    *(u32x4*)(O + off + bj * HALF) = w; } }
    }
};
struct EpiF32Res {
    static constexpr bool MID = false; static constexpr bool PERM = false;
    float* C; const float* base; int ldc;
    __device__ __forceinline__ void operator()(const f32x4 (&acc)[2][2][4][2], const Unit& u, int wr, int wc, int fr, int fq) const {
        const int row0 = u.pm * BM + wr * 64 + fr, col0 = u.pn * BM + wc * 32 + 4 * fq;
#pragma unroll
        for (int ai = 0; ai < 2; ++ai)
#pragma unroll
            for (int m = 0; m < 4; ++m) { const size_t off = (size_t)(row0 + ai * HALF + m * 16) * ldc + col0;
#pragma unroll
                for (int bj = 0; bj < 2; ++bj)
#pragma unroll
                    for (int n = 0; n < 2; ++n) { const f32x4 bs = *(const f32x4*)(base + off + bj * HALF + n * 16); *(f32x4*)(C + off + bj * HALF + n * 16) = acc[ai][bj][m][n] + bs; } }
    }
};
struct EpiSwiGLU {
    static constexpr bool MID = false; static constexpr bool PERM = false;
    bf16_t* H;
    __device__ __forceinline__ void operator()(const f32x4 (&acc)[2][2][4][2], const Unit& u, int wr, int wc, int fr, int fq) const {
        const int row0 = u.pm * BM + wr * 64 + fr;
#pragma unroll
        for (int ai = 0; ai < 2; ++ai)
#pragma unroll
            for (int m = 0; m < 4; ++m) { bf16_t* rowp = H + (size_t)(row0 + ai * HALF + m * 16) * DEXP;
#pragma unroll
                for (int bj = 0; bj < 2; ++bj) { const int G = u.pn * 8 + bj * 4 + wc; const f32x4 g = acc[ai][bj][m][0], up = acc[ai][bj][m][1];
                    u32x2 w; w.x = cvt_pk_bf16(fsilu(g[0]) * up[0], fsilu(g[1]) * up[1]); w.y = cvt_pk_bf16(fsilu(g[2]) * up[2], fsilu(g[3]) * up[3]);
                    *(u32x2*)(rowp + G * 16 + 4 * fq) = w; } }
    }
};

template <int K, class Epi, class Sched>
__device__ __forceinline__ void gemm_phase(LAS unsigned char* lds, const char* Abase, const Sched& S, const Epi& E) {
    const int tid = threadIdx.x, wid = __builtin_amdgcn_readfirstlane(tid >> 6), lane = tid & 63, wr = wid >> 2, wc = wid & 3, fr = lane & 15, fq = lane >> 4;
    constexpr int nt = K / BK;
    int sR[2], sC[2]; unsigned voffB[2];
#pragma unroll
    for (int i = 0; i < 2; ++i) { int R, C; stage_rc(tid * 16 + i * 8192, R, C); sR[i] = R; sC[i] = C; const int Rb = Epi::PERM ? ((R & ~31) + perm32(R & 31)) : R; voffB[i] = (unsigned)(Rb * K + C) * 2u; }
    constexpr size_t kstep = (size_t)(BK * 2);
    constexpr size_t hstep = (size_t)HALF * K * 2;
    const unsigned ldsw = (unsigned)wid * 1024u;
    const int aoff = lds_byte(wr * 64 + fr, fq * 8), boff = lds_byte(wc * 32 + fr, fq * 8);
#define PG8_SA(b, h) (((b) * 2 + (h)) * HTB)
#define PG8_SB(b, h) ((4 + (b) * 2 + (h)) * HTB)
#define PG8_STAGE_B(bufoff, gbase) do { _Pragma("unroll") for (int _i = 0; _i < 2; ++_i) \
        __builtin_amdgcn_global_load_lds((const unsigned*)((const char*)(gbase) + voffB[_i]), (LAS unsigned*)(lds + (bufoff) + ldsw + _i * 8192), 16, 0, 0); } while (0)
#define PG8_STAGE_A(bufoff, gbase, o0, o1) do { \
        __builtin_amdgcn_global_load_lds((const unsigned*)((const char*)(gbase) + (o0)), (LAS unsigned*)(lds + (bufoff) + ldsw), 16, 0, 0); \
        __builtin_amdgcn_global_load_lds((const unsigned*)((const char*)(gbase) + (o1)), (LAS unsigned*)(lds + (bufoff) + ldsw + 8192), 16, 0, 0); } while (0)
#define PG8_LDA(dst, b, h) do { _Pragma("unroll") for (int m = 0; m < 4; ++m) _Pragma("unroll") for (int k = 0; k < 2; ++k) dst[m][k] = *(const LAS bf16x8*)(lds + PG8_SA(b, h) + aoff + m * 2048 + k * 1024); } while (0)
#define PG8_LDB(dst, b, h) do { _Pragma("unroll") for (int n = 0; n < 2; ++n) _Pragma("unroll") for (int k = 0; k < 2; ++k) dst[n][k] = *(const LAS bf16x8*)(lds + PG8_SB(b, h) + boff + n * 2048 + k * 1024); } while (0)
#define PG8_MMA(ai, bj, At, Bt) do { __builtin_amdgcn_s_setprio(1); _Pragma("unroll") for (int m = 0; m < 4; ++m) _Pragma("unroll") for (int n = 0; n < 2; ++n) _Pragma("unroll") for (int k = 0; k < 2; ++k) \
        acc[ai][bj][m][n] = __builtin_amdgcn_mfma_f32_16x16x32_bf16(Bt[n][k], At[m][k], acc[ai][bj][m][n], 0, 0, 0); __builtin_amdgcn_s_setprio(0); } while (0)
#define PG8_WAIT_V(n) asm volatile("s_waitcnt vmcnt(" #n ")" ::: "memory")
#define PG8_WAIT_L(n) asm volatile("s_waitcnt lgkmcnt(" #n ")" ::: "memory")
#define PG8_BAR __builtin_amdgcn_s_barrier()
#define PG8_SCHED __builtin_amdgcn_sched_barrier(0)
    Unit cur, nxt; int ui = 0;
    __syncthreads();
    if (!S.next(0, cur)) return;
    f32x4 acc[2][2][4][2];
#pragma unroll
    for (int a = 0; a < 2; ++a)
#pragma unroll
        for (int b = 0; b < 2; ++b)
#pragma unroll
            for (int m = 0; m < 4; ++m)
#pragma unroll
                for (int n = 0; n < 2; ++n) acc[a][b][m][n] = (f32x4){0.f, 0.f, 0.f, 0.f};
    bf16x8 At[4][2], B0[2][2], B1[2][2];
    unsigned ca00, ca01, ca10, ca11, na00, na01, na10, na11;
    ca00 = S.a_row_off(cur, sR[0]) + sC[0] * 2; ca01 = S.a_row_off(cur, sR[1]) + sC[1] * 2;
    ca10 = S.a_row_off(cur, HALF + sR[0]) + sC[0] * 2; ca11 = S.a_row_off(cur, HALF + sR[1]) + sC[1] * 2;
    const char* cB = cur.B;
    PG8_STAGE_B(PG8_SB(0, 0), cB); PG8_STAGE_A(PG8_SA(0, 0), Abase, ca00, ca01); PG8_STAGE_B(PG8_SB(0, 1), cB + hstep); PG8_STAGE_A(PG8_SA(0, 1), Abase, ca10, ca11);
    if constexpr (Epi::MID) E.begin_unit(cur, tid);
    if (wr == 1) PG8_BAR;
    PG8_WAIT_V(4); PG8_BAR;
    PG8_STAGE_B(PG8_SB(1, 0), cB + kstep); PG8_STAGE_A(PG8_SA(1, 0), Abase + kstep, ca00, ca01); PG8_STAGE_B(PG8_SB(1, 1), cB + hstep + kstep);
    PG8_WAIT_V(6); PG8_BAR;
    for (;;) {
        const bool has_next = S.next(ui + 1, nxt);
        if (has_next) {
            na00 = S.a_row_off(nxt, sR[0]) + sC[0] * 2; na01 = S.a_row_off(nxt, sR[1]) + sC[1] * 2;
            na10 = S.a_row_off(nxt, HALF + sR[0]) + sC[0] * 2; na11 = S.a_row_off(nxt, HALF + sR[1]) + sC[1] * 2;
        } else { na00 = ca00; na01 = ca01; na10 = ca10; na11 = ca11; }
        const char* nB = has_next ? nxt.B : cB;
        for (int t = 0; t < nt; t += 2) {
            if constexpr (Epi::MID) { if (t == nt / 2) { E.mid(acc, wr, fr); E.warm(cur, tid, lds + 131072 + 8192); } }
            const bool last = (t == nt - 2);
            const char* a1 = Abase + (size_t)(t + 1) * kstep;
            const char* a2 = last ? Abase : Abase + (size_t)(t + 2) * kstep; const char* b2 = last ? nB : cB + (size_t)(t + 2) * kstep;
            const char* a3 = a2 + kstep; const char* b3 = b2 + kstep;
            const unsigned x00 = last ? na00 : ca00, x01 = last ? na01 : ca01, x10 = last ? na10 : ca10, x11 = last ? na11 : ca11;
            PG8_LDB(B0, 0, 0); PG8_SCHED; PG8_LDA(At, 0, 0); PG8_STAGE_A(PG8_SA(1, 1), a1, ca10, ca11);
            PG8_WAIT_L(8); PG8_BAR; PG8_WAIT_L(0); PG8_MMA(0, 0, At, B0); PG8_BAR; PG8_SCHED;
            PG8_LDB(B1, 0, 1); PG8_STAGE_B(PG8_SB(0, 0), b2);
            PG8_BAR; PG8_WAIT_L(0); PG8_MMA(0, 1, At, B1); PG8_BAR;
            PG8_LDA(At, 0, 1); PG8_STAGE_A(PG8_SA(0, 0), a2, x00, x01);
            PG8_BAR; PG8_WAIT_L(0); PG8_MMA(1, 0, At, B0); PG8_BAR; PG8_SCHED;
            PG8_STAGE_B(PG8_SB(0, 1), b2 + hstep);
            PG8_WAIT_V(6); PG8_BAR; PG8_MMA(1, 1, At, B1); PG8_BAR;
            PG8_LDB(B0, 1, 0); PG8_SCHED; PG8_LDA(At, 1, 0); PG8_STAGE_A(PG8_SA(0, 1), a2, x10, x11);
            PG8_WAIT_L(8); PG8_BAR; PG8_WAIT_L(0); PG8_MMA(0, 0, At, B0); PG8_BAR; PG8_SCHED;
            PG8_LDB(B1, 1, 1); PG8_STAGE_B(PG8_SB(1, 0), b3);
            PG8_BAR; PG8_WAIT_L(0); PG8_MMA(0, 1, At, B1); PG8_BAR;
            PG8_LDA(At, 1, 1); PG8_STAGE_A(PG8_SA(1, 0), a3, x00, x01);
            PG8_BAR; PG8_WAIT_L(0); PG8_MMA(1, 0, At, B0); PG8_BAR; PG8_SCHED;
            PG8_STAGE_B(PG8_SB(1, 1), b3 + hstep);
            PG8_WAIT_V(6); PG8_BAR; PG8_MMA(1, 1, At, B1); PG8_BAR;
        }
        E(acc, cur, wr, wc, fr, fq);
        if (!has_next) break;
#pragma unroll
        for (int a = 0; a < 2; ++a)
#pragma unroll
            for (int b = 0; b < 2; ++b)
#pragma unroll
                for (int m = 0; m < 4; ++m)
#pragma unroll
                    for (int n = 0; n < 2; ++n) acc[a][b][m][n] = (f32x4){0.f, 0.f, 0.f, 0.f};
        cur = nxt; cB = nB; ca00 = na00; ca01 = na01; ca10 = na10; ca11 = na11; ++ui;
        if constexpr (Epi::MID) E.begin_unit(cur, tid);
    }
    PG8_WAIT_V(0);
    if (wr == 0) PG8_BAR;
    PG8_BAR;
    asm volatile("" ::: "memory"); __syncthreads();
#undef PG8_SA
#undef PG8_SB
#undef PG8_STAGE_A
#undef PG8_STAGE_B
#undef PG8_LDA
#undef PG8_LDB
#undef PG8_MMA
#undef PG8_WAIT_V
#undef PG8_WAIT_L
#undef PG8_BAR
#undef PG8_SCHED
}
}

namespace att {
constexpr int D = 128, NW = 8, QBLK = 32, KVBLK = 64;
constexpr float SCALE = 0.088388347648318440f;
constexpr float THR = 8.f;
constexpr int LDQ = 1024, LDK = 256, LDM = 2048;
constexpr size_t SHM_V = KVBLK * D * 2, SHM_K = KVBLK * D * 2, SHM_ATTN = 2 * SHM_V + 2 * SHM_K + NW * 64 * 4;
#define KSWZ(row, colB) ((row) * 256 + ((colB) ^ (((row) & 7) << 4)))
#define SBAR() __builtin_amdgcn_sched_barrier(0)
__device__ __forceinline__ int crow(int r, int hi) { return (r & 3) + 8 * (r >> 2) + 4 * hi; }
__device__ __forceinline__ void partialSM(f32x16& p0, f32x16& p1, float& m_reg, float& mn, float& alpha) {
  constexpr float C = SCALE * 1.4426950408889634f;
  float pmax = p0[0]; for (int r = 1; r < 16; ++r) pmax = fmaxf(pmax, p0[r]); for (int r = 0; r < 16; ++r) pmax = fmaxf(pmax, p1[r]);
  { auto rr = __builtin_amdgcn_permlane32_swap(__float_as_uint(pmax), __float_as_uint(pmax), false, false);
    pmax = fmaxf(__uint_as_float(rr[0]), __uint_as_float(rr[1])); }
  if (__builtin_expect(__all(pmax - m_reg <= THR / SCALE), 1)) { mn = m_reg; alpha = 1.f; }
  else { mn = fmaxf(m_reg, pmax); alpha = __builtin_amdgcn_exp2f((m_reg - mn) * C); m_reg = mn; }
  float mnC = -mn * C;
  for (int r = 0; r < 16; ++r) p0[r] = fmaf(p0[r], C, mnC); for (int r = 0; r < 16; ++r) p1[r] = fmaf(p1[r], C, mnC);
  for (int r = 0; r < 16; ++r) p0[r] = __builtin_amdgcn_exp2f(p0[r]);
}
__device__ __forceinline__ void finishSM(f32x16& p0, f32x16& p1, float alpha, float& l_reg, bf16x8& pa0, bf16x8& pa1, bf16x8& pa2, bf16x8& pa3) {
  for (int r = 0; r < 16; ++r) p1[r] = __builtin_amdgcn_exp2f(p1[r]);
  float ps = 0; for (int r = 0; r < 16; ++r) ps += p0[r]; for (int r = 0; r < 16; ++r) ps += p1[r];
  { auto rr = __builtin_amdgcn_permlane32_swap(__float_as_uint(ps), __float_as_uint(ps), false, false);
    ps = __uint_as_float(rr[0]) + __uint_as_float(rr[1]); }
  l_reg = l_reg * alpha + ps;
#define PK4(P, BASE, OUT) do { unsigned a0 = cvt_pk_bf16(P[BASE + 0], P[BASE + 1]), a1 = cvt_pk_bf16(P[BASE + 2], P[BASE + 3]);   \
    unsigned b0 = cvt_pk_bf16(P[BASE + 4], P[BASE + 5]), b1 = cvt_pk_bf16(P[BASE + 6], P[BASE + 7]);                              \
    auto r0 = __builtin_amdgcn_permlane32_swap(a0, b0, false, false); auto r1 = __builtin_amdgcn_permlane32_swap(a1, b1, false, false); \
    u32x4 w = {r0[0], r1[0], r0[1], r1[1]}; OUT = *reinterpret_cast<bf16x8*>(&w); } while (0)
  PK4(p0, 0, pa0); PK4(p0, 8, pa1); PK4(p1, 0, pa2); PK4(p1, 8, pa3);
#undef PK4
}
__device__ __forceinline__ void qkt(f32x16& p0, f32x16& p1, const bf16_t* Ks, const bf16x8* qr, int r32, int hi) {
  p0 = f32x16{}; p1 = f32x16{};
  for (int d0 = 0; d0 < 8; ++d0) { int cb = (d0 * 16 + hi * 8) * 2;
    bf16x8 b0 = *reinterpret_cast<const bf16x8*>((const char*)Ks + KSWZ(r32, cb));
    bf16x8 b1 = *reinterpret_cast<const bf16x8*>((const char*)Ks + KSWZ(32 + r32, cb));
    p0 = __builtin_amdgcn_mfma_f32_32x32x16_bf16(b0, qr[d0], p0, 0, 0, 0);
    p1 = __builtin_amdgcn_mfma_f32_32x32x16_bf16(b1, qr[d0], p1, 0, 0, 0); }
}
__device__ __forceinline__ int v_st(int k, int c) { const int kk = (k & ~0xC) | ((k & 4) << 1) | ((k & 8) >> 1); return ((kk >> 3) * 4 + (c >> 5)) * 512 + ((kk & 7) * 32 + (c & 31)) * 2; }
__device__ __forceinline__ int v_rd_base(int lane) { return ((lane & 3) << 3) | (((lane >> 2) & 3) << 6) | (((lane >> 4) & 1) << 5) | (((lane >> 5) & 1) << 8); }
constexpr int v_rd_off(int d0, int ks, int half) { return d0 * 512 + ks * 4096 + half * 2048; }
template <int OFF> __device__ __forceinline__ s16x4 tr_read(int vb) {
  s16x4 r; asm volatile("ds_read_b64_tr_b16 %0, %1 offset:%2" : "=&v"(r) : "v"(vb), "i"(OFF) : "memory"); return r;
}
template <int D0> __device__ __forceinline__ void pv_one(f32x16& od, int vb, bf16x8 pa0, bf16x8 pa1, bf16x8 pa2, bf16x8 pa3) {
  const s16x4 l0 = tr_read<v_rd_off(D0, 0, 0)>(vb), h0 = tr_read<v_rd_off(D0, 0, 1)>(vb), l1 = tr_read<v_rd_off(D0, 1, 0)>(vb), h1 = tr_read<v_rd_off(D0, 1, 1)>(vb);
  const s16x4 l2 = tr_read<v_rd_off(D0, 2, 0)>(vb), h2 = tr_read<v_rd_off(D0, 2, 1)>(vb), l3 = tr_read<v_rd_off(D0, 3, 0)>(vb), h3 = tr_read<v_rd_off(D0, 3, 1)>(vb);
  asm volatile("s_waitcnt lgkmcnt(0)" ::: "memory"); SBAR();
#define PK(L, H) (bf16x8){L[0], L[1], L[2], L[3], H[0], H[1], H[2], H[3]}
  od = __builtin_amdgcn_mfma_f32_32x32x16_bf16(pa0, PK(l0, h0), od, 0, 0, 0);
  od = __builtin_amdgcn_mfma_f32_32x32x16_bf16(pa1, PK(l1, h1), od, 0, 0, 0);
  od = __builtin_amdgcn_mfma_f32_32x32x16_bf16(pa2, PK(l2, h2), od, 0, 0, 0);
  od = __builtin_amdgcn_mfma_f32_32x32x16_bf16(pa3, PK(l3, h3), od, 0, 0, 0);
#undef PK
}
__device__ __forceinline__ void pv_d0(f32x16* o, int vb, bf16x8 pa0, bf16x8 pa1, bf16x8 pa2, bf16x8 pa3) {
  pv_one<0>(o[0], vb, pa0, pa1, pa2, pa3); pv_one<1>(o[1], vb, pa0, pa1, pa2, pa3); pv_one<2>(o[2], vb, pa0, pa1, pa2, pa3); pv_one<3>(o[3], vb, pa0, pa1, pa2, pa3);
}
__device__ __forceinline__ void attn_dense_body(const bf16_t* __restrict__ Qb, const bf16_t* __restrict__ Kh, const bf16_t* __restrict__ Vh,
                                                bf16_t* __restrict__ Ob, float* __restrict__ Sq, int seq, char* lds) {
  const int tid = threadIdx.x, wid = tid >> 6, lane = tid & 63, r32 = lane & 31, hi = lane >> 5;
  bf16_t* V_lds = (bf16_t*)lds; bf16_t* K_lds = (bf16_t*)(lds + 2 * SHM_V);
  float* ws = (float*)(lds + 2 * SHM_V + 2 * SHM_K) + wid * 64; float* li_l = ws; float* al_l = ws + 32;
  float m_reg = -1e30f, l_reg = 0; f32x16 o[4] = {}; bf16x8 qr[8];
  const bf16_t* Qw = Qb + (long)(wid * QBLK + r32) * LDQ + hi * 8;
#pragma unroll
  for (int d0 = 0; d0 < 8; ++d0) qr[d0] = *reinterpret_cast<const bf16x8*>(Qw + d0 * 16);
  const int sr = tid >> 4, sc = (tid & 15) * 8, vst0 = v_st(sr, sc), vst1 = v_st(32 + sr, sc);
  const int vb0 = (int)(uintptr_t)V_lds + v_rd_base(lane);
  struct { bf16x8 vs0, vs1, ks0, ks1; } sr_[2];
#define SLOAD(i, k0) do { sr_[i].vs0 = *reinterpret_cast<const bf16x8*>(&Vh[(long)((k0) + sr) * LDK + sc]); sr_[i].vs1 = *reinterpret_cast<const bf16x8*>(&Vh[(long)((k0) + 32 + sr) * LDK + sc]); \
    sr_[i].ks0 = *reinterpret_cast<const bf16x8*>(&Kh[(long)((k0) + sr) * LDK + sc]); sr_[i].ks1 = *reinterpret_cast<const bf16x8*>(&Kh[(long)((k0) + 32 + sr) * LDK + sc]); } while (0)
#define SWRITE(b, i) do { *(bf16x8*)((char*)V_lds + (b) * SHM_V + vst0) = sr_[i].vs0;          \
    *(bf16x8*)((char*)V_lds + (b) * SHM_V + vst1) = sr_[i].vs1; int kc = sc * 2;               \
    *(bf16x8*)((char*)K_lds + (b) * SHM_K + KSWZ(sr, kc)) = sr_[i].ks0;                       \
    *(bf16x8*)((char*)K_lds + (b) * SHM_K + KSWZ(32 + sr, kc)) = sr_[i].ks1; } while (0)
#define SWAIT() asm volatile("s_waitcnt vmcnt(4)" ::: "memory")
#define RESC(a) do { if (__any((a) < 1.f)) { if (hi == 0) al_l[r32] = (a); asm volatile("s_waitcnt lgkmcnt(0)" ::: "memory"); \
    for (int d = 0; d < 4; ++d) for (int r = 0; r < 16; ++r) o[d][r] *= al_l[crow(r, hi)]; } } while (0)
  f32x16 pA0, pA1, pB0, pB1; float mnA, mnB, alA, alB; bf16x8 pa0, pa1, pa2, pa3; const int NT = seq / KVBLK;
  constexpr int SE = 0, SO = 1;
  SLOAD(SE, 0); asm volatile("s_waitcnt vmcnt(0)" ::: "memory"); SWRITE(0, SE); __syncthreads();
  qkt(pA0, pA1, K_lds, qr, r32, hi);
#pragma unroll
  for (int r = 8; r < 16; ++r) pA0[r] = -1e30f;
#pragma unroll
  for (int r = 0; r < 16; ++r) pA1[r] = -1e30f;
  partialSM(pA0, pA1, m_reg, mnA, alA);
  SLOAD(SO, KVBLK); if (2 < NT) SLOAD(SE, 2 * KVBLK);
  SWAIT(); SWRITE(1, SO); __syncthreads();
  for (int j = 1; j + 1 < NT; j += 2) {
    SBAR(); qkt(pB0, pB1, (bf16_t*)((char*)K_lds + SHM_K), qr, r32, hi);
    finishSM(pA0, pA1, alA, l_reg, pa0, pa1, pa2, pa3); SBAR();
    SLOAD(SO, (j + 2) * KVBLK); SBAR();
    pv_d0(o, vb0, pa0, pa1, pa2, pa3); partialSM(pB0, pB1, m_reg, mnB, alB);
    __syncthreads(); SWAIT(); SWRITE(0, SE);
    RESC(alB); __syncthreads();
    SBAR(); qkt(pA0, pA1, K_lds, qr, r32, hi);
    finishSM(pB0, pB1, alB, l_reg, pa0, pa1, pa2, pa3); SBAR();
    if (j + 3 < NT) SLOAD(SE, (j + 3) * KVBLK); SBAR();
    pv_d0(o, vb0 + (int)SHM_V, pa0, pa1, pa2, pa3); partialSM(pA0, pA1, m_reg, mnA, alA);
    __syncthreads(); SWAIT(); SWRITE(1, SO);
    RESC(alA); __syncthreads();
  }
  SBAR(); qkt(pB0, pB1, (bf16_t*)((char*)K_lds + SHM_K), qr, r32, hi);
#pragma unroll
  for (int r = 0; r < 16; ++r) { pB0[r] = -1e30f; pB1[r] = -1e30f; }
  finishSM(pA0, pA1, alA, l_reg, pa0, pa1, pa2, pa3); SBAR();
  pv_d0(o, vb0, pa0, pa1, pa2, pa3); partialSM(pB0, pB1, m_reg, mnB, alB);
  __syncthreads(); RESC(alB);
  finishSM(pB0, pB1, alB, l_reg, pa0, pa1, pa2, pa3); SBAR();
  pv_d0(o, vb0 + (int)SHM_V, pa0, pa1, pa2, pa3);
  if (hi == 0) li_l[r32] = l_reg; asm volatile("s_waitcnt lgkmcnt(0)" ::: "memory");
  float rli[16];
#pragma unroll
  for (int r = 0; r < 16; ++r) rli[r] = __builtin_amdgcn_rcpf(li_l[crow(r, hi)]);
  __syncthreads();
  char* st = lds + wid * 16384;
  {
    int ln = lane; asm volatile("" : "+v"(ln));
    const int r32e = ln & 31, hie = ln >> 5;
    char* sb[4];
#pragma unroll
    for (int c = 0; c < 4; ++c) sb[c] = st + hie * 2048 + ((((r32e >> 2) ^ (4 * hie)) ^ c) * 16) + (r32e & 3) * 4;
#pragma unroll
    for (int r = 0; r < 16; ++r)
#pragma unroll
      for (int d0 = 0; d0 < 4; ++d0) *(float*)(sb[r & 3] + ((r & 3) + 8 * (r >> 2)) * 512 + ((d0 ^ (r >> 2)) * 128)) = o[d0][r] * rli[r]; }
  asm volatile("s_waitcnt lgkmcnt(0)" ::: "memory");
  { int ln = lane; asm volatile("" : "+v"(ln)); const int row = ln >> 1, half = ln & 1; float ss = 0.f;
    bf16_t* dst = Ob + (long)(wid * QBLK + row) * LDM + half * 64;
#pragma unroll
    for (int i = 0; i < 16; i += 2) { const f32x4 a = *(const f32x4*)(st + row * 512 + (((half * 16 + i) ^ row) & 31) * 16), b = *(const f32x4*)(st + row * 512 + (((half * 16 + i + 1) ^ row) & 31) * 16);
      ss += a[0] * a[0] + a[1] * a[1] + a[2] * a[2] + a[3] * a[3] + b[0] * b[0] + b[1] * b[1] + b[2] * b[2] + b[3] * b[3];
      u32x4 w; w.x = cvt_pk_bf16(a[0], a[1]); w.y = cvt_pk_bf16(a[2], a[3]); w.z = cvt_pk_bf16(b[0], b[1]); w.w = cvt_pk_bf16(b[2], b[3]);
      *(u32x4*)(dst + i * 4) = w; }
    Sq[(long)(wid * QBLK + row) * 16 + half] = ss; }
  __syncthreads();
#undef SLOAD
#undef SWRITE
#undef SWAIT
#undef RESC
}
}

struct Ctx { int tid, lane, wave, G, bid; LAS unsigned char* lds; unsigned char* ws; int xcc, xrank; };

template <class DstRow>
__device__ __forceinline__ void cvt_tile(const float* __restrict__ src, int C, int r0, int c0, bf16_t* __restrict__ dst, int ldd, DstRow dstrow, LAS float* tile, int dk0, const float* __restrict__ rs) {
    const int t = threadIdx.x, c4 = (t & 63) * 4, rr = t >> 6;
    f32x4 v[8];
#pragma unroll
    for (int i = 0; i < 8; ++i) { v[i] = *(const f32x4*)(src + (size_t)(r0 + rr + 8 * i) * C + c0 + c4); if (rs) v[i] = v[i] * rs[r0 + rr + 8 * i]; }
    __syncthreads();
#pragma unroll
    for (int i = 0; i < 8; ++i) *(LAS f32x4*)(tile + (rr + 8 * i) * 260 + c4) = v[i];
    __syncthreads();
    const int dc = t & 255, half = t >> 8;
    bf16_t* drow = dst + (size_t)dstrow(c0 + dc) * ldd + dk0 + 32 * half;
#pragma unroll
    for (int k8 = 0; k8 < 4; ++k8) { u32x4 w;
#pragma unroll
        for (int j = 0; j < 4; ++j) { const float lo = tile[(32 * half + 8 * k8 + 2 * j) * 260 + dc], hi = tile[(32 * half + 8 * k8 + 2 * j + 1) * 260 + dc]; w[j] = cvt_pk_bf16(lo, hi); }
        *(u32x4*)(drow + 8 * k8) = w; }
}
struct RowId { __device__ __forceinline__ int operator()(int c) const { return c; } };
struct RowGU { int add; __device__ __forceinline__ int operator()(int c) const { return 32 * (c >> 4) + add + (c & 15); } };

__device__ __forceinline__ void p0_prologue(const Params& p, const Ctx& F) {
    LAS float* tile = (LAS float*)F.lds;
    bf16_t* win = (bf16_t*)(F.ws + WS_WIN);
    constexpr int J_WIN = 32 * 18;
    for (int j = F.bid; j < J_WIN; j += F.G) { const int tr = j / 18, tc = j % 18; cvt_tile(p.w_in, INW, tr * 64, tc * 256, win, DM, RowId{}, tile, tr * 64, nullptr); }
    bf16_t* abf = (bf16_t*)(F.ws + WS_ABF);
    constexpr int RJ = 8;
    int r_lo = 0, r_n = 0; bool even = true;
    { const int G = F.G, base = (MROWS + RJ * J_WIN) / G; int sum = 0, lo = 0, mine = 0; bool ok = true;
      for (int c = 0; c < G; ++c) { const int tiles = c < J_WIN ? (J_WIN - 1 - c) / G + 1 : 0; const int rc = base - RJ * tiles; if (rc < 0) ok = false;
          if (c == F.bid) { lo = sum; mine = rc; } sum += rc; }
      const int rem = MROWS - sum;
      if (ok && rem >= 0 && rem <= G) { even = false; r_lo = lo + (F.bid < rem ? F.bid : rem); r_n = mine + (F.bid < rem ? 1 : 0); } }
    const int gw = even ? F.bid * 8 + F.wave : r_lo + F.wave, nw = even ? F.G * 8 : 8, n_end = even ? MROWS : r_lo + r_n;
    for (int n = gw; n < n_end; n += nw) {
        bf16_t* dst = abf + (size_t)n * DM;
        if (n < PADN || n >= LP) {
#pragma unroll
            for (int i = 0; i < 8; ++i) *(u32x2*)(dst + (F.lane + 64 * i) * 4) = (u32x2){0u, 0u};
        } else {
            const float* src = (n < PREFIX) ? p.meta + (size_t)(n - PADN) * DM : p.x + (size_t)(n - PREFIX) * DM;
            f32x4 v[8]; float ss = 0.f;
#pragma unroll
            for (int i = 0; i < 8; ++i) { v[i] = *(const f32x4*)(src + (F.lane + 64 * i) * 4); ss += v[i][0] * v[i][0] + v[i][1] * v[i][1] + v[i][2] * v[i][2] + v[i][3] * v[i][3]; }
            ss = wave_sum(ss); const float rstd = rsqrtf(ss * (1.0f / DM) + 1e-6f);
#pragma unroll
            for (int i = 0; i < 8; ++i) { const f32x4 g = *(const f32x4*)(p.norm_mix_g + (F.lane + 64 * i) * 4);
                u32x2 w; w.x = cvt_pk_bf16(v[i][0] * rstd * g[0], v[i][1] * rstd * g[1]); w.y = cvt_pk_bf16(v[i][2] * rstd * g[2], v[i][3] * rstd * g[3]);
                *(u32x2*)(dst + (F.lane + 64 * i) * 4) = w; }
        }
    }
    const int gt = F.bid * NTHREADS + F.tid, ntot = F.G * NTHREADS;
    f32x2* tabq = (f32x2*)(F.ws + WS_TABQ); f32x2* tabr = (f32x2*)(F.ws + WS_TABR);
    for (int i = gt; i < 128 * 48; i += ntot) {
        int pos, fi; float fr;
        if (i < 128 * 32) { pos = i >> 5; fi = i & 31; fr = exp2f(-(float)(2 * fi) * (13.287712379549449f / 64.0f)); }
        else { const int q = i - 128 * 32; pos = q >> 4; fi = q & 15; fr = exp2f(-(float)(2 * fi) * (13.287712379549449f / 32.0f)); }
        const float ang = (float)pos * fr; float rev = ang * 0.15915494309189535f; rev -= rintf(rev);
        const f32x2 cs = {__builtin_amdgcn_cosf(rev), __builtin_amdgcn_sinf(rev)};
        if (i < 128 * 32) tabq[i] = cs; else tabr[i - 128 * 32] = cs;
    }
}

__device__ __forceinline__ void p1_side_jobs(const Params& p, const Ctx& F, int nunits) {
    const int r = nunits % F.G, lo = r == 0 ? 0 : r, nid = F.G - lo;
    if (F.bid < lo) return;
    const int c = F.bid - lo;
    LAS float* tile = (LAS float*)F.lds; bf16_t* wout = (bf16_t*)(F.ws + WS_WOUT);
    for (int q = c; q < 32 * 8; q += nid) { const int tr = q / 8, tc = q % 8; cvt_tile(p.w_out, DM, tr * 64, tc * 256, wout, DM, RowId{}, tile, (tr * 64) ^ 1024, tr >= 16 ? p.attn_out_g - 1024 : nullptr); }
    const int gt = c * NTHREADS + F.tid, ntot = nid * NTHREADS;
    bf16_t* wrh = (bf16_t*)(F.ws + WS_WR);
    for (int i = gt; i < DM * 80; i += ntot) { const int j = i / DM, k = i % DM; const float g = p.norm_ffn_g[k];
        const float v = j < 8 ? g * p.wg[k * 8 + j] : (j < 72 ? g * p.we[k * 64 + (j - 8)] : 0.f);
        wrh[i] = (bf16_t)(cvt_pk_bf16(v, 0.f) & 0xffffu); }
}

__device__ __forceinline__ void p2_post(const Params& p, const Ctx& F) {
    const bf16_t* proj = (const bf16_t*)(F.ws + WS_PROJ);
    bf16_t* rq = (bf16_t*)(F.ws + WS_RQ); bf16_t* rk = (bf16_t*)(F.ws + WS_RK); bf16_t* aq = (bf16_t*)(F.ws + WS_AQ); bf16_t* ak = (bf16_t*)(F.ws + WS_AK); bf16_t* av = (bf16_t*)(F.ws + WS_AV);
    const f32x2* tabq = (const f32x2*)(F.ws + WS_TABQ); const f32x2* tabr = (const f32x2*)(F.ws + WS_TABR);
    const int lane = F.lane, tot = LP + 112, qb = tot / F.G, qr = tot % F.G;
    const int n_lo = F.bid * qb + (F.bid < qr ? F.bid : qr), n_hi = n_lo + qb + (F.bid < qr ? 1 : 0);
    for (int n = n_lo + F.wave; n < n_hi; n += 8) {
        if (n >= LP) {
            const int z = n - LP; const int slot = z < 48 ? 16 + z : 8256 + (z - 48);
            *(u32x2*)(ak + (size_t)slot * 256 + lane * 4) = (u32x2){0u, 0u}; *(u32x2*)(av + (size_t)slot * 256 + lane * 4) = (u32x2){0u, 0u};
            continue;
        }
        const bf16_t* pr = proj + (size_t)n * INW;
        int prow = 0, pcol = 0; if (n >= PREFIX) { const int t = n - PREFIX; prow = t >> 6; pcol = t & 63; }
        const int hd = lane >> 2, jr = (lane & 3) * 4, hh = lane >> 3, ja = (lane & 7) * 4, hk = hh < 2 ? hh : 0;
        const bf16_t* sr_ = pr + hd * 64 + jr; const bf16_t* sq_ = pr + C_AQ + hh * 128 + ja; const bf16_t* sk_ = pr + C_AK + hk * 128 + ja;
        const u32x2 ra1 = *(const u32x2*)(sr_), ra2 = *(const u32x2*)(sr_ + 16), rb1 = *(const u32x2*)(sr_ + 32), rb2 = *(const u32x2*)(sr_ + 48);
        const u32x2 qa1 = *(const u32x2*)(sq_), qa2 = *(const u32x2*)(sq_ + 32), qb1 = *(const u32x2*)(sq_ + 64), qb2 = *(const u32x2*)(sq_ + 96);
        const u32x2 ka1 = *(const u32x2*)(sk_), ka2 = *(const u32x2*)(sk_ + 32), kb1 = *(const u32x2*)(sk_ + 64), kb2 = *(const u32x2*)(sk_ + 96);
        const u32x2 vv = *(const u32x2*)(pr + C_AV + lane * 4);
        f32x2 trr[4], trc[4], tqr[4], tqc[4];
#pragma unroll
        for (int i = 0; i < 4; ++i) { trr[i] = tabr[prow * 16 + jr + i]; trc[i] = tabr[pcol * 16 + jr + i]; tqr[i] = tabq[prow * 32 + ja + i]; tqc[i] = tabq[pcol * 32 + ja + i]; }
        {
            const int j0 = jr; const u32x2 a1 = ra1, a2 = ra2, b1 = rb1, b2 = rb2;
            float x1r[4] = {bf_lo(a1.x), bf_hi(a1.x), bf_lo(a1.y), bf_hi(a1.y)}, x2r[4] = {bf_lo(a2.x), bf_hi(a2.x), bf_lo(a2.y), bf_hi(a2.y)};
            float x1c[4] = {bf_lo(b1.x), bf_hi(b1.x), bf_lo(b1.y), bf_hi(b1.y)}, x2c[4] = {bf_lo(b2.x), bf_hi(b2.x), bf_lo(b2.y), bf_hi(b2.y)};
            const float sc = hd >= 8 ? 0.125f : 1.0f;
            float o1r[4], o2r[4], o1c[4], o2c[4];
#pragma unroll
            for (int i = 0; i < 4; ++i) { const f32x2 cr = trr[i], cc = trc[i];
                o1r[i] = (x1r[i] * cr.x - x2r[i] * cr.y) * sc; o2r[i] = (x2r[i] * cr.x + x1r[i] * cr.y) * sc;
                o1c[i] = (x1c[i] * cc.x - x2c[i] * cc.y) * sc; o2c[i] = (x2c[i] * cc.x + x1c[i] * cc.y) * sc; }
            bf16_t* d = (hd >= 8 ? rk : rq) + (size_t)n * 512 + (hd & 7) * 64 + j0;
            *(u32x2*)(d) = (u32x2){cvt_pk_bf16(o1r[0], o1r[1]), cvt_pk_bf16(o1r[2], o1r[3])}; *(u32x2*)(d + 16) = (u32x2){cvt_pk_bf16(o2r[0], o2r[1]), cvt_pk_bf16(o2r[2], o2r[3])};
            *(u32x2*)(d + 32) = (u32x2){cvt_pk_bf16(o1c[0], o1c[1]), cvt_pk_bf16(o1c[2], o1c[3])}; *(u32x2*)(d + 48) = (u32x2){cvt_pk_bf16(o2c[0], o2c[1]), cvt_pk_bf16(o2c[2], o2c[3])};
        }
        if (n < PADN) continue;
        const int slot = n < PREFIX ? n - PADN : 64 + (n - PREFIX);
#pragma unroll
        for (int pass = 0; pass < 2; ++pass) {
            if (pass == 0 && n < PREFIX) continue;
            const int j0 = ja; const bool act = pass == 0 || hh < 2; const int hc = act ? hh : 0;
            const float* g = pass == 0 ? p.gq : p.gk;
            const u32x2 a1 = pass == 0 ? qa1 : ka1, a2 = pass == 0 ? qa2 : ka2, b1 = pass == 0 ? qb1 : kb1, b2 = pass == 0 ? qb2 : kb2;
            float x1r[4] = {bf_lo(a1.x), bf_hi(a1.x), bf_lo(a1.y), bf_hi(a1.y)}, x2r[4] = {bf_lo(a2.x), bf_hi(a2.x), bf_lo(a2.y), bf_hi(a2.y)};
            float x1c[4] = {bf_lo(b1.x), bf_hi(b1.x), bf_lo(b1.y), bf_hi(b1.y)}, x2c[4] = {bf_lo(b2.x), bf_hi(b2.x), bf_lo(b2.y), bf_hi(b2.y)};
            float ss = 0.f;
#pragma unroll
            for (int i = 0; i < 4; ++i) ss += x1r[i] * x1r[i] + x2r[i] * x2r[i] + x1c[i] * x1c[i] + x2c[i] * x2c[i];
            ss += __shfl_xor(ss, 1); ss += __shfl_xor(ss, 2); ss += __shfl_xor(ss, 4);
            const float rstd = rsqrtf(ss * (1.0f / 128.0f) + 1e-6f);
            float o1r[4], o2r[4], o1c[4], o2c[4];
#pragma unroll
            for (int i = 0; i < 4; ++i) { const f32x2 cr = tqr[i], cc = tqc[i];
                const float y1r = x1r[i] * rstd * g[j0 + i], y2r = x2r[i] * rstd * g[32 + j0 + i], y1c = x1c[i] * rstd * g[64 + j0 + i], y2c = x2c[i] * rstd * g[96 + j0 + i];
                o1r[i] = y1r * cr.x - y2r * cr.y; o2r[i] = y2r * cr.x + y1r * cr.y; o1c[i] = y1c * cc.x - y2c * cc.y; o2c[i] = y2c * cc.x + y1c * cc.y; }
            if (act) { bf16_t* d = pass == 0 ? aq + (size_t)(n - PREFIX) * 1024 + hc * 128 + j0 : ak + (size_t)slot * 256 + hc * 128 + j0;
                *(u32x2*)(d) = (u32x2){cvt_pk_bf16(o1r[0], o1r[1]), cvt_pk_bf16(o1r[2], o1r[3])}; *(u32x2*)(d + 32) = (u32x2){cvt_pk_bf16(o2r[0], o2r[1]), cvt_pk_bf16(o2r[2], o2r[3])};
                *(u32x2*)(d + 64) = (u32x2){cvt_pk_bf16(o1c[0], o1c[1]), cvt_pk_bf16(o1c[2], o1c[3])}; *(u32x2*)(d + 96) = (u32x2){cvt_pk_bf16(o2c[0], o2c[1]), cvt_pk_bf16(o2c[2], o2c[3])}; }
        }
        *(u32x2*)(av + (size_t)slot * 256 + lane * 4) = vv;
    }
}

__device__ __forceinline__ float log2_gamma(float logit) { return -log1pf(__expf(-logit)) * 1.4426950408889634f; }

__device__ __forceinline__ void p3_ret_state(const Params& p, const Ctx& F) {
    const bf16_t* proj = (const bf16_t*)(F.ws + WS_PROJ); const bf16_t* rk = (const bf16_t*)(F.ws + WS_RK); float* ust = (float*)(F.ws + WS_UST);
    constexpr int VS = 288, KS = 160;
    constexpr unsigned OV = 0, OKF = 128 * VS, OKB = OKF + 128 * KS;
    const int t = F.tid, lane = F.lane, w = F.wave;
    LAS unsigned char* vl = F.lds + OV + tr_lane_off(lane, VS); LAS unsigned char* kfl = F.lds + OKF + tr_lane_off(lane, KS); LAS unsigned char* kbl = F.lds + OKB + tr_lane_off(lane, KS);
    u32x4 vraw[4], kraw[2];
#define P3_LOAD(uu) do { const int _c = (uu) >> 3, _h = (uu) & 7, _row = t >> 2; const bf16_t* _vs = proj + (size_t)(_c * 128 + _row) * INW + C_RV + _h * 128; const bf16_t* _ks = rk + (size_t)(_c * 128 + _row) * 512 + _h * 64; \
        _Pragma("unroll") for (int _i = 0; _i < 4; ++_i) vraw[_i] = *(const u32x4*)(_vs + ((t & 3) + 4 * _i) * 8); \
        _Pragma("unroll") for (int _i = 0; _i < 2; ++_i) kraw[_i] = *(const u32x4*)(_ks + ((t & 3) + 4 * _i) * 8); } while (0)
    if (F.bid < NCHUNK * 8) P3_LOAD(F.bid);
    for (int u = F.bid; u < NCHUNK * 8; u += F.G) {
        const int c = u >> 3, h = u & 7;
        const float lgf = log2_gamma(p.lf[h]), lgb = log2_gamma(p.lb[h]);
        __syncthreads();
        {   const int row = t >> 2;
#pragma unroll
            for (int i = 0; i < 4; ++i) { const int ch = (t & 3) + 4 * i; *(LAS u32x4*)(F.lds + OV + row * VS + ch * 16) = vraw[i]; }
            const float wf = exp2f(lgf * (float)(127 - row)), wb = exp2f(lgb * (float)row);
#pragma unroll
            for (int i = 0; i < 2; ++i) { const int ch = (t & 3) + 4 * i; const u32x4 kv = kraw[i]; u32x4 kf, kb;
#pragma unroll
                for (int q = 0; q < 4; ++q) { const float lo = bf_lo(kv[q]), hi = bf_hi(kv[q]); kf[q] = cvt_pk_bf16(lo * wf, hi * wf); kb[q] = cvt_pk_bf16(lo * wb, hi * wb); }
                *(LAS u32x4*)(F.lds + OKF + row * KS + ch * 16) = kf; *(LAS u32x4*)(F.lds + OKB + row * KS + ch * 16) = kb; }
        }
        if (u + F.G < NCHUNK * 8) P3_LOAD(u + F.G);
        __syncthreads();
        f32x4 af[4], ab[4];
#pragma unroll
        for (int i = 0; i < 4; ++i) { af[i] = (f32x4){0.f, 0.f, 0.f, 0.f}; ab[i] = (f32x4){0.f, 0.f, 0.f, 0.f}; }
#pragma unroll
        for (int s = 0; s < 4; ++s) {
            const bf16x8 a = tr_frag(vl, VS, 32 * s, 16 * w);
#pragma unroll
            for (int db = 0; db < 4; ++db) {
                const bf16x8 bf = tr_frag(kfl, KS, 32 * s, 16 * db), bb = tr_frag(kbl, KS, 32 * s, 16 * db);
                af[db] = __builtin_amdgcn_mfma_f32_16x16x32_bf16(a, bf, af[db], 0, 0, 0);
                ab[db] = __builtin_amdgcn_mfma_f32_16x16x32_bf16(a, bb, ab[db], 0, 0, 0);
            }
        }
        const int g = lane >> 4, r = lane & 15;
        float* of = ust + ((size_t)(c * 8 + h) * 2 + 0) * 8192; float* ob = of + 8192;
#pragma unroll
        for (int db = 0; db < 4; ++db)
#pragma unroll
            for (int reg = 0; reg < 4; ++reg) { const int e = 16 * w + 4 * g + reg, d = 16 * db + r; of[e * 64 + d] = af[db][reg]; ob[e * 64 + d] = ab[db][reg]; }
    }
}

#undef P3_LOAD
__device__ __forceinline__ void p4_ret_scan(const Params& p, const Ctx& F) {
    const float* ust = (const float*)(F.ws + WS_UST); bf16_t* sst = (bf16_t*)(F.ws + WS_SST);
    constexpr int CS = 8 * 2 * 8192;
    for (int idx = F.bid * NTHREADS + F.tid; idx < 8 * 2 * 8192; idx += F.G * NTHREADS) {
        const int dir = (idx >> 13) & 1, h = idx >> 14;
        const float lg = log2_gamma(dir ? p.lb[h] : p.lf[h]); const float g128 = exp2f(lg * 128.0f);
        float s = 0.f;
        float u[64];
        if (dir == 0) {
#pragma unroll
            for (int i = 0; i < 64; ++i) u[i] = ust[(size_t)i * CS + idx];
#pragma unroll
            for (int i = 0; i < 64; ++i) { s = g128 * s + u[i]; sst[(size_t)(i + 1) * CS + idx] = (bf16_t)(cvt_pk_bf16(s, 0.f) & 0xffffu); }
        } else {
#pragma unroll
            for (int i = 0; i < 64; ++i) u[i] = ust[(size_t)(64 - i) * CS + idx];
            sst[(size_t)64 * CS + idx] = 0;
#pragma unroll
            for (int i = 0; i < 64; ++i) { s = g128 * s + u[i]; if (63 - i >= 1) sst[(size_t)(63 - i) * CS + idx] = (bf16_t)(cvt_pk_bf16(s, 0.f) & 0xffffu); }
        }
    }
}

__device__ __forceinline__ void p5_ret_out(const Params& p, const Ctx& F) {
    const bf16_t* proj = (const bf16_t*)(F.ws + WS_PROJ); const bf16_t* rq = (const bf16_t*)(F.ws + WS_RQ); const bf16_t* rk = (const bf16_t*)(F.ws + WS_RK);
    const bf16_t* sst = (const bf16_t*)(F.ws + WS_SST); bf16_t* mixa = (bf16_t*)(F.ws + WS_MIXA);
    constexpr int VS = 288, RS = 144;
    constexpr unsigned OV = 0, OK_ = 128 * VS, OS = OK_ + 128 * RS, OT = OS + 128 * RS, OO = OT + 128 * RS; constexpr int OSTR = 272;
    const int t = F.tid, lane = F.lane, w = F.wave, g = lane >> 4, r = lane & 15;
    LAS unsigned char* vl = F.lds + OV + tr_lane_off(lane, VS);
    for (int u = F.bid; u < 64 * 8; u += F.G) {
        const int c = 1 + (u >> 3), h = u & 7;
        const float lgf = log2_gamma(p.lf[h]), lgb = log2_gamma(p.lb[h]);
        __syncthreads();
        {   const int row = t >> 2;
            const bf16_t* vsrc = proj + (size_t)(c * 128 + row) * INW + C_RV + h * 128;
#pragma unroll
            for (int i = 0; i < 4; ++i) { const int ch = (t & 3) + 4 * i; *(LAS u32x4*)(F.lds + OV + row * VS + ch * 16) = *(const u32x4*)(vsrc + ch * 8); }
            const bf16_t* ksrc = rk + (size_t)(c * 128 + row) * 512 + h * 64;
            const bf16_t* ssrc = sst + ((size_t)(c * 8 + h) * 2 + 0) * 8192 + row * 64; const bf16_t* tsrc = ssrc + 8192;
#pragma unroll
            for (int i = 0; i < 2; ++i) { const int ch = (t & 3) + 4 * i;
                *(LAS u32x4*)(F.lds + OK_ + row * RS + ch * 16) = *(const u32x4*)(ksrc + ch * 8);
                *(LAS u32x4*)(F.lds + OS + row * RS + ch * 16) = *(const u32x4*)(ssrc + ch * 8);
                *(LAS u32x4*)(F.lds + OT + row * RS + ch * 16) = *(const u32x4*)(tsrc + ch * 8); }
        }
        bf16x8 qf[2];
        { const bf16_t* qsrc = rq + (size_t)(c * 128 + 16 * w + r) * 512 + h * 64 + 8 * g; qf[0] = *(const bf16x8*)(qsrc); qf[1] = *(const bf16x8*)(qsrc + 32); }
        __syncthreads();
        f32x4 sc[8];
#pragma unroll
        for (int kb = 0; kb < 8; ++kb) { sc[kb] = (f32x4){0.f, 0.f, 0.f, 0.f};
#pragma unroll
            for (int ks = 0; ks < 2; ++ks) { const bf16x8 kf = *(const LAS bf16x8*)(F.lds + OK_ + (16 * kb + r) * RS + (32 * ks + 8 * g) * 2);
                sc[kb] = __builtin_amdgcn_mfma_f32_16x16x32_bf16(kf, qf[ks], sc[kb], 0, 0, 0); } }
        const int iq = 16 * w + r;
#pragma unroll
        for (int kb = 0; kb < 8; ++kb)
#pragma unroll
            for (int reg = 0; reg < 4; ++reg) { const int j = 16 * kb + 4 * g + reg, df = iq - j;
                const float dec = df >= 0 ? exp2f(lgf * (float)df) : exp2f(lgb * (float)(-df)); sc[kb][reg] *= dec; }
        bf16x8 pf[4];
#pragma unroll
        for (int s = 0; s < 4; ++s) { u32x4 wv; wv.x = cvt_pk_bf16(sc[2 * s][0], sc[2 * s][1]); wv.y = cvt_pk_bf16(sc[2 * s][2], sc[2 * s][3]);
            wv.z = cvt_pk_bf16(sc[2 * s + 1][0], sc[2 * s + 1][1]); wv.w = cvt_pk_bf16(sc[2 * s + 1][2], sc[2 * s + 1][3]); pf[s] = *reinterpret_cast<bf16x8*>(&wv); }
        float sf[4], sb[4];
#pragma unroll
        for (int reg = 0; reg < 4; ++reg) { const int i = 16 * w + 4 * g + reg; sf[reg] = exp2f(lgf * (float)(i + 1)); sb[reg] = exp2f(lgb * (float)(128 - i)); }
        f32x4 o[8];
#pragma unroll
        for (int eb = 0; eb < 8; ++eb) {
            f32x4 acc = (f32x4){0.f, 0.f, 0.f, 0.f};
#pragma unroll
            for (int s = 0; s < 4; ++s) { const bf16x8 vf = tr_frag(vl, VS, 32 * s, 16 * eb); acc = __builtin_amdgcn_mfma_f32_16x16x32_bf16(pf[s], vf, acc, 0, 0, 0); }
            f32x4 xs = (f32x4){0.f, 0.f, 0.f, 0.f}, xt = (f32x4){0.f, 0.f, 0.f, 0.f};
#pragma unroll
            for (int ks = 0; ks < 2; ++ks) {
                const bf16x8 sfr = *(const LAS bf16x8*)(F.lds + OS + (16 * eb + r) * RS + (32 * ks + 8 * g) * 2);
                const bf16x8 tfr = *(const LAS bf16x8*)(F.lds + OT + (16 * eb + r) * RS + (32 * ks + 8 * g) * 2);
                xs = __builtin_amdgcn_mfma_f32_16x16x32_bf16(qf[ks], sfr, xs, 0, 0, 0);
                xt = __builtin_amdgcn_mfma_f32_16x16x32_bf16(qf[ks], tfr, xt, 0, 0, 0); }
#pragma unroll
            for (int reg = 0; reg < 4; ++reg) acc[reg] += sf[reg] * xs[reg] + sb[reg] * xt[reg];
            o[eb] = acc;
        }
#pragma unroll
        for (int eb = 0; eb < 8; ++eb) { const int e = 16 * eb + r;
#pragma unroll
            for (int reg = 0; reg < 4; ++reg) { const int i = 16 * w + 4 * g + reg;
                *(LAS bf16_t*)(F.lds + OO + i * OSTR + e * 2) = (bf16_t)(cvt_pk_bf16(o[eb][reg], 0.f) & 0xffffu); } }
        u32x4 gq0, gq1, gq2, gq3;
        { const bf16_t* gsrc0 = proj + ((size_t)c * 128 + (t >> 2)) * INW + C_RG + h * 128 + (t & 3) * 8;
          gq0 = *(const u32x4*)(gsrc0); gq1 = *(const u32x4*)(gsrc0 + 32); gq2 = *(const u32x4*)(gsrc0 + 64); gq3 = *(const u32x4*)(gsrc0 + 96); }
        __syncthreads();
        {   const int row = t >> 2; const size_t n = (size_t)c * 128 + row;
            float s1 = 0.f, sq = 0.f;
#pragma unroll 4
            for (int k = 0; k < 16; ++k) { const u32x4 rv = *(const LAS u32x4*)(F.lds + OO + row * OSTR + k * 16);
#pragma unroll
                for (int q = 0; q < 4; ++q) { const float a = bf_lo(rv[q]), b = bf_hi(rv[q]); s1 += a + b; sq += a * a + b * b; } }
            const float mu = s1 * (1.0f / 128.0f); const float s2 = fmaxf(sq - 128.0f * mu * mu, 0.f);
            const float rstd = rsqrtf(s2 * (1.0f / 128.0f) + 1e-5f);
            bf16_t* dst = mixa + (n - PREFIX) * DM + 1024 + h * 128; const float* gnp = p.ret_norm_g + h * 128;
#pragma unroll 1
            for (int i = 0; i < 4; ++i) { const int ch = (t & 3) + 4 * i; const u32x4 gv = i == 0 ? gq0 : (i == 1 ? gq1 : (i == 2 ? gq2 : gq3)); const f32x4 g0 = *(const f32x4*)(gnp + ch * 8), g1 = *(const f32x4*)(gnp + ch * 8 + 4);
                const u32x4 yv = *(const LAS u32x4*)(F.lds + OO + row * OSTR + ch * 16); u32x4 ov;
                ov[0] = cvt_pk_bf16(fsilu(bf_lo(gv[0])) * ((bf_lo(yv[0]) - mu) * rstd * g0[0]), fsilu(bf_hi(gv[0])) * ((bf_hi(yv[0]) - mu) * rstd * g0[1]));
                ov[1] = cvt_pk_bf16(fsilu(bf_lo(gv[1])) * ((bf_lo(yv[1]) - mu) * rstd * g0[2]), fsilu(bf_hi(gv[1])) * ((bf_hi(yv[1]) - mu) * rstd * g0[3]));
                ov[2] = cvt_pk_bf16(fsilu(bf_lo(gv[2])) * ((bf_lo(yv[2]) - mu) * rstd * g1[0]), fsilu(bf_hi(gv[2])) * ((bf_hi(yv[2]) - mu) * rstd * g1[1]));
                ov[3] = cvt_pk_bf16(fsilu(bf_lo(gv[3])) * ((bf_lo(yv[3]) - mu) * rstd * g1[2]), fsilu(bf_hi(gv[3])) * ((bf_hi(yv[3]) - mu) * rstd * g1[3]));
                *(u32x4*)(dst + ch * 8) = ov; }
        }
    }
}

__device__ __forceinline__ void p5_attention(const Params& p, const Ctx& F) {
    const bf16_t* aq = (const bf16_t*)(F.ws + WS_AQ); const bf16_t* ak = (const bf16_t*)(F.ws + WS_AK); const bf16_t* av = (const bf16_t*)(F.ws + WS_AV);
    bf16_t* mixa = (bf16_t*)(F.ws + WS_MIXA); float* ssq = (float*)(F.ws + WS_ATTO);
    for (int u = F.bid; u < 32 * 8; u += F.G) {
        const int h = u & 7, qb = u >> 3, kvh = h >> 2;
        att::attn_dense_body(aq + (size_t)qb * 256 * 1024 + h * 128, ak + kvh * 128, av + kvh * 128, mixa + (size_t)qb * 256 * DM + h * 128, ssq + (size_t)qb * 256 * 16 + h * 2, NKEY, (char*)F.lds);
    }
}

__device__ __forceinline__ void p6_mixprep(const Params& p, const Ctx& F) {
    const float* ssq = (const float*)(F.ws + WS_ATTO); bf16_t* mixa = (bf16_t*)(F.ws + WS_MIXA);
    const int gw = F.bid * 8 + F.wave, nw = F.G * 8, lane = F.lane;
    for (int t = gw; t < SEQ; t += nw) {
        const f32x4 s0 = *(const f32x4*)(ssq + (size_t)t * 16), s1 = *(const f32x4*)(ssq + (size_t)t * 16 + 4), s2 = *(const f32x4*)(ssq + (size_t)t * 16 + 8), s3 = *(const f32x4*)(ssq + (size_t)t * 16 + 12);
        const float ss = ((s0[0] + s0[1]) + (s0[2] + s0[3])) + ((s1[0] + s1[1]) + (s1[2] + s1[3])) + ((s2[0] + s2[1]) + (s2[2] + s2[3])) + ((s3[0] + s3[1]) + (s3[2] + s3[3]));
        const float rstd = rsqrtf(ss * (1.0f / 1024.0f) + 1e-6f);
#pragma unroll
        for (int i = 0; i < 4; ++i) { const int c = (lane + 64 * i) * 4; const f32x4 g = *(const f32x4*)(p.attn_out_g + c); const u32x2 v = *(const u32x2*)(mixa + (size_t)t * DM + c);
            u32x2 w; w.x = cvt_pk_bf16(bf_lo(v.x) * rstd * g[0], bf_hi(v.x) * rstd * g[1]); w.y = cvt_pk_bf16(bf_lo(v.y) * rstd * g[2], bf_hi(v.y) * rstd * g[3]);
            *(u32x2*)(mixa + (size_t)t * DM + c) = w; }
    }
}

__device__ __forceinline__ void p8_router(const Params& p, const Ctx& F) {
    const bf16_t* h1 = (const bf16_t*)(F.ws + WS_H1); const bf16_t* wrh = (const bf16_t*)(F.ws + WS_WR); unsigned char* fbf = (unsigned char*)(F.ws + WS_FBF);
    unsigned* cnt = (unsigned*)(F.ws + WS_CTL + CTL_CNT); int* list = (int*)(F.ws + WS_LIST); unsigned* route = (unsigned*)(F.ws + WS_ROUTE);
    LAS float* part = (LAS float*)F.lds;
    LAS float* pss = (LAS float*)(F.lds + 8 * 32 * 80 * 4);
    LAS float* prs = pss + 8 * 32;
    const int lane = F.lane, w = F.wave, r = lane & 15, q = lane >> 4;
    for (int blk = F.bid; blk < SEQ / 32; blk += F.G) {
        const int t0 = blk * 32;
        f32x4 acc[2][5];
#pragma unroll
        for (int tl = 0; tl < 2; ++tl)
#pragma unroll
            for (int nb = 0; nb < 5; ++nb) acc[tl][nb] = (f32x4){0.f, 0.f, 0.f, 0.f};
        float ss[2] = {0.f, 0.f};
        const __amdgpu_buffer_rsrc_t hrs = __builtin_amdgcn_make_buffer_rsrc((void*)h1, 0, 0x7fffffff, 0x00020000);
        const __amdgpu_buffer_rsrc_t wrs = __builtin_amdgcn_make_buffer_rsrc((void*)wrh, 0, 0x7fffffff, 0x00020000);
        const unsigned avo = (unsigned)((t0 + r) * DM + w * 256 + 8 * q) * 2u, bvo = (unsigned)(r * DM + w * 256 + 8 * q) * 2u;
        u32x4 xa[4][2], wh[4][5];
#define P8_LOAD(XA, WH, s) do { _Pragma("unroll") for (int tl = 0; tl < 2; ++tl) XA[tl] = __builtin_amdgcn_raw_buffer_load_b128(hrs, avo, tl * 16 * DM * 2 + (s) * 64, 0); \
        _Pragma("unroll") for (int nb = 0; nb < 5; ++nb) WH[nb] = __builtin_amdgcn_raw_buffer_load_b128(wrs, bvo, nb * 16 * DM * 2 + (s) * 64, 0); } while (0)
#define P8_MMA(XA, WH) do { _Pragma("unroll") for (int tl = 0; tl < 2; ++tl) { const u32x4 hv = XA[tl]; \
            _Pragma("unroll") for (int c4 = 0; c4 < 4; ++c4) { const float lo_ = bf_lo(hv[c4]), hi_ = bf_hi(hv[c4]); ss[tl] += lo_ * lo_ + hi_ * hi_; } \
            const bf16x8 ah = *reinterpret_cast<const bf16x8*>(&hv); \
            _Pragma("unroll") for (int nb = 0; nb < 5; ++nb) acc[tl][nb] = __builtin_amdgcn_mfma_f32_16x16x32_bf16(ah, *reinterpret_cast<const bf16x8*>(&WH[nb]), acc[tl][nb], 0, 0, 0); } } while (0)
        P8_LOAD(xa[0], wh[0], 0); P8_LOAD(xa[1], wh[1], 1); P8_LOAD(xa[2], wh[2], 2); __builtin_amdgcn_sched_barrier(0);
#pragma unroll
        for (int s = 0; s < 8; ++s) {
            if (s + 3 < 8) P8_LOAD(xa[(s + 3) & 3], wh[(s + 3) & 3], s + 3);
            __builtin_amdgcn_sched_barrier(0);
            P8_MMA(xa[s & 3], wh[s & 3]); __builtin_amdgcn_sched_barrier(0);
        }
#undef P8_LOAD
#undef P8_MMA
#pragma unroll
        for (int tl = 0; tl < 2; ++tl) { ss[tl] += __shfl_xor(ss[tl], 16); ss[tl] += __shfl_xor(ss[tl], 32); }
        __syncthreads();
#pragma unroll
        for (int tl = 0; tl < 2; ++tl) {
#pragma unroll
            for (int nb = 0; nb < 5; ++nb)
#pragma unroll
                for (int reg = 0; reg < 4; ++reg) part[(w * 32 + tl * 16 + 4 * q + reg) * 80 + nb * 16 + r] = acc[tl][nb][reg];
            if (q == 0) pss[w * 32 + tl * 16 + r] = ss[tl]; }
        __syncthreads();
        if (F.tid < 32) { float s2 = 0.f;
#pragma unroll
            for (int k = 0; k < 8; ++k) s2 += pss[k * 32 + F.tid];
            prs[F.tid] = rsqrtf(s2 * (1.0f / DM) + 1e-6f); }
        __syncthreads();
        if (F.tid < 32) {
            const int t = blk * 32 + F.tid;
            const float rstd = prs[F.tid];
            float gl[8]; float gmax = -3.0e38f; int gi = 0;
#pragma unroll
            for (int j = 0; j < 8; ++j) { float a = 0.f;
#pragma unroll
                for (int k = 0; k < 8; ++k) a += part[(k * 32 + F.tid) * 80 + j];
                gl[j] = a * rstd + p.bg[j]; if (gl[j] > gmax) { gmax = gl[j]; gi = j; } }
            float den = 0.f;
#pragma unroll
            for (int j = 0; j < 8; ++j) den += __expf(gl[j] - gmax);
            const float gw = 1.0f / den;
            float v1 = -3.0e38f, v2 = -3.0e38f; int i1 = 0, i2 = 0;
            for (int j = 0; j < 8; ++j) { float a = 0.f; const int col = 8 + gi * 8 + j;
#pragma unroll
                for (int k = 0; k < 8; ++k) a += part[(k * 32 + F.tid) * 80 + col];
                const float el = a * rstd + p.be[gi * 8 + j];
                if (el > v1) { v2 = v1; i2 = i1; v1 = el; i1 = j; } else if (el > v2) { v2 = el; i2 = j; } }
            const float e2 = __expf(v2 - v1); const float w0 = gw / (1.0f + e2), w1 = gw * e2 / (1.0f + e2);
            const int e0 = gi * 8 + i1, e1 = gi * 8 + i2;
            const unsigned p0 = atomicAdd(&cnt[e0], 1u), p1 = atomicAdd(&cnt[e1], 1u);
            __hip_atomic_store(list + (size_t)e0 * SEQ + p0, t, __ATOMIC_RELAXED, __HIP_MEMORY_SCOPE_AGENT);
            __hip_atomic_store(list + (size_t)e1 * SEQ + p1, t, __ATOMIC_RELAXED, __HIP_MEMORY_SCOPE_AGENT);
            unsigned* ro = route + (size_t)t * 8; ro[0] = (unsigned)e0; ro[1] = (unsigned)e1; ro[2] = p0; ro[3] = p1; ro[4] = __float_as_uint(w0); ro[5] = __float_as_uint(w1);
        }
#pragma unroll 1
        for (int i0 = 0; i0 < 4; i0 += 2) {
            u32x2 hv[2][8];
#pragma unroll
            for (int i = 0; i < 2; ++i)
#pragma unroll
                for (int k = 0; k < 8; ++k) hv[i][k] = *(const u32x2*)(h1 + (size_t)(blk * 32 + w * 4 + i0 + i) * DM + (lane + 64 * k) * 4);
#pragma unroll
            for (int k = 0; k < 8; ++k) { const int c = (lane + 64 * k) * 4; const f32x4 g = *(const f32x4*)(p.norm_ffn_g + c);
#pragma unroll
                for (int i = 0; i < 2; ++i) { const int tl = w * 4 + i0 + i, t = blk * 32 + tl; const float rstd = prs[tl]; const u32x2 h = hv[i][k];
                    *(unsigned*)(fbf + (size_t)t * DM + c) = pk4_fp8(bf_lo(h.x) * rstd * g[0], bf_hi(h.x) * rstd * g[1], bf_lo(h.y) * rstd * g[2], bf_hi(h.y) * rstd * g[3]); } }
        }
    }
}

struct MoeTab { LAS int* eoff; LAS int* ord; };
__device__ __forceinline__ MoeTab moe_table(const Ctx& F, const bool compute) {
    MoeTab T; T.eoff = (LAS int*)(F.lds + LDS_MISC + 1024); T.ord = T.eoff + 80;
    if (!compute) return T;
    unsigned* cnt = (unsigned*)(F.ws + WS_CTL + CTL_CNT);
    __syncthreads();
    if (F.tid == 64) {
        unsigned* bw = (unsigned*)(F.ws + WS_CTL); int nx = 0, nloc = 1, xord = 0;
        for (int j = 0; j < 16; ++j) { const int c = (int)__hip_atomic_load(bw + XB_XCNT(j), __ATOMIC_RELAXED, __HIP_MEMORY_SCOPE_AGENT); if (c > 0) { ++nx; if (j < F.xcc) ++xord; } if (j == F.xcc) nloc = c; }
        if (nx < 1) nx = 1; if (nloc < 1) nloc = 1;
        T.eoff[144] = nx; T.eoff[145] = nloc; T.eoff[146] = xord; }
    if (F.tid < 64) {
        const int c = (int)__hip_atomic_load(cnt + F.tid, __ATOMIC_RELAXED, __HIP_MEMORY_SCOPE_AGENT); int s = c;
#pragma unroll
        for (int o = 1; o < 64; o <<= 1) { const int v = __shfl_up(s, o); if (F.tid >= o) s += v; }
        T.eoff[F.tid] = s - c; if (F.tid == 63) T.eoff[64] = s;
        int rank = 0;
        for (int k = 0; k < 64; ++k) { const int ck = __shfl(c, k); rank += (ck > c || (ck == c && k < F.tid)) ? 1 : 0; }
        T.ord[rank] = F.tid; }
    __syncthreads();
    return T;
}

template <int K, bool GU, int NACT>
__device__ __forceinline__ void moe_pass(const Ctx& F, const __amdgpu_buffer_rsrc_t wrs, const __amdgpu_buffer_rsrc_t ars, const unsigned wvo, const unsigned (&avo)[3][2], const unsigned wofs,
                                         const unsigned rbB, const unsigned ra, unsigned char* outp, int m0, int ne, int slab,
                                         const __amdgpu_buffer_rsrc_t wrs_n, const int pf_ld) {
    constexpr int NT = K / 64, NP = NT / 2, ldw = GU ? DEXP : DM, NA = NACT > 0 ? NACT : 1;
    constexpr float WSC = GU ? 64.0f : 32.0f;
    const int lane = F.lane, w = F.wave, r = lane & 15, kq = lane >> 4;
    LAS unsigned char* abase = F.lds + 16384 + w * 12288;
    const unsigned awo = (unsigned)((lane >> 3) * 128 + (((lane & 7) ^ ((lane >> 4) & 7)) * 16));
    f32x4 acc[NA][8];
#pragma unroll
    for (int j = 0; j < NA; ++j)
#pragma unroll
        for (int nb = 0; nb < 8; ++nb) acc[j][nb] = (f32x4){0.f, 0.f, 0.f, 0.f};
    f32x4 sB0[4], sB1[4]; u32x4 sA[NA][2]; unsigned pfv = 0;
#define MG_LOADB(S, t) do { _Pragma("unroll") for (int _j = 0; _j < 4; ++_j) { const u32x4 _v = __builtin_amdgcn_raw_buffer_load_b128(wrs, wvo, ((t) * 64 + _j) * ldw * 4, 0); S[_j] = *(const f32x4*)&_v; } } while (0)
#define MG_STOREB(S, buf) do { _Pragma("unroll") for (int _i = 0; _i < 4; ++_i) \
        *(LAS unsigned*)(F.lds + (buf) * 8192 + wofs + _i * 64) = pk4_fp8(S[0][_i] * WSC, S[1][_i] * WSC, S[2][_i] * WSC, S[3][_i] * WSC); } while (0)
#define MG_LOADA(pr) do { if (NACT > 0) { _Pragma("unroll") for (int _j = 0; _j < NA; ++_j) _Pragma("unroll") for (int _i = 0; _i < 2; ++_i) \
        sA[_j][_i] = __builtin_amdgcn_raw_buffer_load_b128(ars, avo[_j][_i], (pr) * 128, 0); } } while (0)
#define MG_STOREA(ao) do { if (NACT > 0) { _Pragma("unroll") for (int _j = 0; _j < NA; ++_j) _Pragma("unroll") for (int _i = 0; _i < 2; ++_i) \
        *(LAS u32x4*)(abase + (ao) + _j * 2048 + _i * 1024 + (awo ^ (_i * 64))) = sA[_j][_i]; } } while (0)
#define MG_COMPUTE(h, buf, ao) do { if (NACT > 0) { long _a[NA][2]; \
        _Pragma("unroll") for (int _j = 0; _j < NA; ++_j) { _a[_j][0] = *(const LAS long*)(abase + (ao) + _j * 2048 + (ra ^ (unsigned)((4 * (h)) * 16))); \
                                                             _a[_j][1] = *(const LAS long*)(abase + (ao) + _j * 2048 + (ra ^ (unsigned)((4 * (h) + 2) * 16))); } \
        _Pragma("unroll") for (int _nb = 0; _nb < 8; ++_nb) { \
        const long _b0 = *(const LAS long*)(F.lds + (buf) * 8192 + _nb * 1024 + rbB), _b1 = *(const LAS long*)(F.lds + (buf) * 8192 + _nb * 1024 + (rbB ^ 32u)); \
        _Pragma("unroll") for (int _j = 0; _j < NA; ++_j) { \
            acc[_j][_nb] = __builtin_amdgcn_mfma_f32_16x16x32_fp8_fp8(_b0, _a[_j][0], acc[_j][_nb], 0, 0, 0); \
            acc[_j][_nb] = __builtin_amdgcn_mfma_f32_16x16x32_fp8_fp8(_b1, _a[_j][1], acc[_j][_nb], 0, 0, 0); } \
        if ((_nb & 1) == 1) __builtin_amdgcn_sched_barrier(0); } } } while (0)
#define MG_SB __builtin_amdgcn_sched_barrier(0)
    MG_LOADB(sB0, 0); MG_LOADB(sB1, 1); MG_LOADA(0);
    __syncthreads();
    MG_STOREB(sB0, 0); MG_STOREA(0); MG_LOADA(1); MG_LOADB(sB0, 2);
    __syncthreads();
    int ap = 0;
    for (int P = 0; P + 2 < NP; ++P) {
        const int t = 2 * P;
        MG_STOREB(sB1, 1); MG_LOADB(sB1, t + 3); MG_SB; MG_COMPUTE(0, 0, ap); __syncthreads();
        MG_STOREB(sB0, 0); MG_STOREA(6144 - ap); MG_LOADA(P + 2); MG_LOADB(sB0, t + 4); MG_SB; MG_COMPUTE(1, 1, ap); __syncthreads();
        ap = 6144 - ap;
    }
    {
        MG_STOREB(sB1, 1); MG_LOADB(sB1, NT - 1); MG_SB; MG_COMPUTE(0, 0, ap); __syncthreads();
        MG_STOREB(sB0, 0); MG_STOREA(6144 - ap); MG_SB; MG_COMPUTE(1, 1, ap); __syncthreads();
        ap = 6144 - ap;
        if (pf_ld > 0) { const int t8 = F.tid & 255; pfv = __builtin_amdgcn_raw_buffer_load_b32(wrs_n, (unsigned)((((t8 >> 7) * 64 + ((t8 >> 1) & 63)) * pf_ld + (t8 & 1) * 32) * 4), 0, 0); }
        MG_STOREB(sB1, 1); MG_SB; MG_COMPUTE(0, 0, ap); __syncthreads();
        MG_COMPUTE(1, 1, ap); __syncthreads();
    }
#undef MG_SB
#undef MG_LOADB
#undef MG_STOREB
#undef MG_LOADA
#undef MG_STOREA
#undef MG_COMPUTE
    if (NACT > 0) {
#pragma unroll
        for (int j = 0; j < NA; ++j) { int m = m0 + 16 * (w + 8 * j) + r; asm volatile("" : "+v"(m));
            if (m < ne) {
                if (GU) {
                    unsigned d[4];
#pragma unroll
                    for (int nb = 0; nb < 4; ++nb) { const f32x4 g = acc[j][nb] * (1.0f / 64.0f), up = acc[j][nb + 4] * (8.0f / 64.0f);
                        d[nb] = pk4_fp8(fsilu(g[0]) * up[0], fsilu(g[1]) * up[1], fsilu(g[2]) * up[2], fsilu(g[3]) * up[3]); }
                    const auto s01 = __builtin_amdgcn_permlane16_swap(d[0], d[1], false, false), s23 = __builtin_amdgcn_permlane16_swap(d[2], d[3], false, false);
                    const auto t02 = __builtin_amdgcn_permlane32_swap(s01[0], s23[0], false, false), t13 = __builtin_amdgcn_permlane32_swap(s01[1], s23[1], false, false);
                    *(u32x4*)(outp + (size_t)m * DEXP + slab * 64 + 16 * kq) = (u32x4){t02[0], t13[0], t02[1], t13[1]}; }
                else {
                    bf16_t* dst = (bf16_t*)outp + (size_t)m * DM + slab * 128 + 16 * (kq & 1) + 8 * (kq >> 1);
#pragma unroll
                    for (int nb = 0; nb < 8; nb += 2) { const f32x4 v0 = acc[j][nb] * (1.0f / 256.0f), v1 = acc[j][nb + 1] * (1.0f / 256.0f);
                        const auto rx = __builtin_amdgcn_permlane16_swap(cvt_pk_bf16(v0[0], v0[1]), cvt_pk_bf16(v1[0], v1[1]), false, false);
                        const auto ry = __builtin_amdgcn_permlane16_swap(cvt_pk_bf16(v0[2], v0[3]), cvt_pk_bf16(v1[2], v1[3]), false, false);
                        *(u32x4*)(dst + 16 * nb) = (u32x4){rx[0], ry[0], rx[1], ry[1]}; } }
            } }
    }    asm volatile("" :: "v"(pfv));
}
template <int K, bool GU>
__device__ __forceinline__ void moe_gemm(const Params& p, const Ctx& F, const MoeTab& T) {
    const int tid = F.tid, lane = F.lane, w = F.wave, r = lane & 15, kq = lane >> 4;
    const int kg = (tid >> 4) & 15, ng = (tid & 15) + 16 * (tid >> 8);
    const unsigned char* fbf = (const unsigned char*)(F.ws + WS_FBF); unsigned char* hb = (unsigned char*)(F.ws + WS_HB); bf16_t* yb = (bf16_t*)(F.ws + WS_YB);
    const int* list = (const int*)(F.ws + WS_LIST);
    const unsigned wofs = (unsigned)((4 * ng) * 64 + (((kg >> 2) ^ (ng & 3)) * 16) + (kg & 3) * 4);
    const unsigned rbB = (unsigned)(r * 64 + (((kq >> 1) ^ ((r >> 2) & 3)) * 16) + (kq & 1) * 8);
    const unsigned ra = (unsigned)(r * 128 + (((kq >> 1) ^ ((r >> 1) & 7)) * 16) + (kq & 1) * 8);
    constexpr int ldw = GU ? DEXP : DM;
    const unsigned wvo = (unsigned)((4 * kg) * ldw + 4 * (tid & 15)) * 4u;
    const int nx = T.eoff[144], nloc = T.eoff[145], xord = T.eoff[146];
    const int nexp_x = (NEXP - xord + nx - 1) / nx;
    auto unit_rsrc = [&](bool dn, int e, int slab) -> __amdgpu_buffer_rsrc_t {
        const char* wbase;
        if (!dn) wbase = (const char*)((w < 4 ? p.w_gate : p.w_up) + (size_t)e * DM * DEXP + slab * 64);
        else wbase = (const char*)(p.w_down + (size_t)e * DEXP * DM + slab * 128 + (w < 4 ? 0 : 64));
        const unsigned long long wb = (unsigned long long)wbase; const unsigned lo = __builtin_amdgcn_readfirstlane((unsigned)wb), hi = __builtin_amdgcn_readfirstlane((unsigned)(wb >> 32));
        wbase = (const char*)(((unsigned long long)hi << 32) | lo);
        return __builtin_amdgcn_make_buffer_rsrc((void*)wbase, 0, 0x7fffffff, 0x00020000); };
    const int gpx = nloc >> 4, ngr = nx * gpx; const bool bal = (nloc & 15) == 0 && gpx > 0 && (NEXP % ngr) == 0;
    const int per = bal ? NEXP / ngr : 0, grp = xord * gpx + (F.xrank >> 4);
    auto unit_at = [&](int i) -> int {
        if (bal) { if (i >= per) return -1; return (T.ord[i * ngr + ((i & 1) ? ngr - 1 - grp : grp)] << 4) | (F.xrank & 15); }
        const int q = F.xrank + i * nloc; if (q >= nexp_x * 16) return -1; return ((xord + (q >> 4) * nx) << 4) | (q & 15); };
    for (int i = 0; ; ++i) {
        const int ue = unit_at(i); if (ue < 0) break;
        const int e = ue >> 4, slab = ue & 15;
        const int e0 = T.eoff[e], ne = T.eoff[e + 1] - e0;
        const __amdgpu_buffer_rsrc_t wrs = unit_rsrc(!GU, e, slab);
        const int un = unit_at(i + 1); const bool haven = un >= 0; const int u0 = unit_at(0);
        const int en = haven ? un >> 4 : u0 >> 4, slabn = haven ? (un & 15) : (u0 & 15);
        const bool nextdn = haven ? !GU : true;
        const __amdgpu_buffer_rsrc_t wrsn = unit_rsrc(nextdn, en, slabn);
        const int ldn = (haven || GU) ? (nextdn ? DM : DEXP) : 0;
        const char* abase = GU ? (const char*)fbf : (const char*)(hb + (size_t)e0 * DEXP);
        { const unsigned long long ab = (unsigned long long)abase; const unsigned lo = __builtin_amdgcn_readfirstlane((unsigned)ab), hi = __builtin_amdgcn_readfirstlane((unsigned)(ab >> 32));
          abase = (const char*)(((unsigned long long)hi << 32) | lo); }
        const __amdgpu_buffer_rsrc_t ars = __builtin_amdgcn_make_buffer_rsrc((void*)abase, 0, 0x7fffffff, 0x00020000);
        unsigned char* outp = GU ? hb + (size_t)e0 * DEXP : (unsigned char*)(yb + (size_t)e0 * DM);
        for (int m0 = 0; m0 < ne; m0 += 384) {
            unsigned avo[3][2];
#pragma unroll
            for (int j = 0; j < 3; ++j)
#pragma unroll
                for (int i2 = 0; i2 < 2; ++i2) { int m = m0 + 16 * (w + 8 * j) + (lane >> 3) + 8 * i2; const bool past = m >= ne; if (past) m = ne - 1;
                    if (GU) { const int tok = list[(size_t)e * SEQ + m]; avo[j][i2] = (unsigned)tok * (unsigned)DM + 16u * (lane & 7); }
                    else avo[j][i2] = (unsigned)m * (unsigned)DEXP + 16u * (lane & 7);
                    if (past) avo[j][i2] = 0x80000000u; }
            int nact = 0;
#pragma unroll
            for (int j = 0; j < 3; ++j) if (m0 + 16 * (w + 8 * j) < ne) nact = j + 1;
            const bool lastp = m0 + 384 >= ne;
            if (nact == 3) moe_pass<K, GU, 3>(F, wrs, ars, wvo, avo, wofs, rbB, ra, outp, m0, ne, slab, lastp ? wrsn : wrs, lastp ? ldn : ldw);
            else if (nact == 2) moe_pass<K, GU, 2>(F, wrs, ars, wvo, avo, wofs, rbB, ra, outp, m0, ne, slab, lastp ? wrsn : wrs, lastp ? ldn : ldw);
            else if (nact == 1) moe_pass<K, GU, 1>(F, wrs, ars, wvo, avo, wofs, rbB, ra, outp, m0, ne, slab, lastp ? wrsn : wrs, lastp ? ldn : ldw);
            else moe_pass<K, GU, 0>(F, wrs, ars, wvo, avo, wofs, rbB, ra, outp, m0, ne, slab, lastp ? wrsn : wrs, lastp ? ldn : ldw);
        }
    }
}

__device__ __forceinline__ void p11_final(const Params& p, const Ctx& F) {
    const bf16_t* h1 = (const bf16_t*)(F.ws + WS_H1); const bf16_t* yb = (const bf16_t*)(F.ws + WS_YB); const unsigned* route = (const unsigned*)(F.ws + WS_ROUTE);
    const MoeTab T = moe_table(F, MK_TABLE_EVERY_PHASE);
    const int gw = F.bid * 8 + F.wave, nw = F.G * 8, lane = F.lane;
    u32x4 rA = (u32x4){0u, 0u, 0u, 0u}; u32x2 rB = (u32x2){0u, 0u};
    if (gw < SEQ) { rA = *(const u32x4*)(route + (size_t)gw * 8); rB = *(const u32x2*)(route + (size_t)gw * 8 + 4); }
    for (int t = gw; t < SEQ; t += nw) {
        const u32x4 cA = rA; const u32x2 cB = rB;
        if (t + nw < SEQ) { rA = *(const u32x4*)(route + (size_t)(t + nw) * 8); rB = *(const u32x2*)(route + (size_t)(t + nw) * 8 + 4); }
        const int e0 = (int)cA[0], e1 = (int)cA[1]; const size_t s0 = (size_t)T.eoff[e0] + cA[2], s1 = (size_t)T.eoff[e1] + cA[3];
        const float w0 = __uint_as_float(cB[0]), w1 = __uint_as_float(cB[1]);
        f32x4 v[8]; float ss = 0.f;
#pragma unroll
        for (int i = 0; i < 8; ++i) { const int c = (lane + 64 * i) * 4; { const u32x2 hh = *(const u32x2*)(h1 + (size_t)t * DM + c); v[i] = (f32x4){bf_lo(hh.x), bf_hi(hh.x), bf_lo(hh.y), bf_hi(hh.y)}; }
            const u32x2 a = *(const u32x2*)(yb + s0 * DM + c), b = *(const u32x2*)(yb + s1 * DM + c);
            v[i][0] += w0 * bf_lo(a.x) + w1 * bf_lo(b.x); v[i][1] += w0 * bf_hi(a.x) + w1 * bf_hi(b.x); v[i][2] += w0 * bf_lo(a.y) + w1 * bf_lo(b.y); v[i][3] += w0 * bf_hi(a.y) + w1 * bf_hi(b.y);
            ss += v[i][0] * v[i][0] + v[i][1] * v[i][1] + v[i][2] * v[i][2] + v[i][3] * v[i][3]; }
        ss = wave_sum(ss); const float rstd = rsqrtf(ss * (1.0f / DM) + 1e-6f);
#pragma unroll
        for (int i = 0; i < 8; ++i) { const int c = (lane + 64 * i) * 4; const f32x4 g = *(const f32x4*)(p.norm_final_g + c);
            *(f32x4*)(p.out + (size_t)t * DM + c) = (f32x4){v[i][0] * rstd * g[0], v[i][1] * rstd * g[1], v[i][2] * rstd * g[2], v[i][3] * rstd * g[3]}; }
    }
}

constexpr int N_PHASES = 12;
__global__ void __launch_bounds__(NTHREADS, 2) mk_fwd(Params p) {
    extern __shared__ __attribute__((aligned(16))) unsigned char lds_raw[];
    Ctx F; F.lds = (LAS unsigned char*)lds_raw; F.tid = threadIdx.x; F.lane = F.tid & 63; F.wave = __builtin_amdgcn_readfirstlane(F.tid >> 6); F.G = gridDim.x; F.bid = blockIdx.x; F.ws = p.ws;
    volatile LAS unsigned* misc = (volatile LAS unsigned*)(F.lds + LDS_MISC);
    if (F.tid < 4) misc[F.tid] = 0u;
    if (F.tid == 0) { const unsigned x = xb_xcc_id(); misc[4] = x; misc[5] = xb_add((unsigned*)(F.ws + WS_CTL + CTL_XRANK) + 64 * x, 1u); }
    __syncthreads();
    F.xcc = (int)misc[4]; F.xrank = (int)misc[5];
    const int lo = p.ph_lo, hi = p.ph_hi;
    XcdBarrier bar; bar.bar = (unsigned*)(F.ws + WS_CTL); bar.x = 0; bar.st = misc;
    if (hi - lo > 1) bar = xcd_barrier_post((unsigned*)(F.ws + WS_CTL), misc);
#ifdef ONLY_PHASE
#define IN(k) ((k) == ONLY_PHASE && lo <= (k) && (k) < hi)
#else
#define IN(k) (lo <= (k) && (k) < hi)
#endif
#define SEAM(k) do { if (IN(k) && IN((k) + 1)) xcd_barrier(bar); } while (0)
#ifndef PROBE_REP_MASK
#define PROBE_REP_MASK 0
#endif
#define RUN(k, ...) do { if (IN(k)) { __VA_ARGS__; if ((PROBE_REP_MASK >> (k)) & 1) { xcd_barrier(bar); __VA_ARGS__; } } SEAM(k); } while (0)
    RUN(0, p0_prologue(p, F));
    RUN(1, { pg8::StaticOrder S; S.init(MROWS, INW, DM, F.ws + WS_WIN, F.G, F.bid); pg8::EpiBf16 E{(bf16_t*)(F.ws + WS_PROJ), INW};
        pg8::gemm_phase<DM>(F.lds, (const char*)(F.ws + WS_ABF), S, E); p1_side_jobs(p, F, (MROWS / 256) * (INW / 256)); });
    RUN(2, p2_post(p, F));
    RUN(3, p3_ret_state(p, F));
    RUN(4, p4_ret_scan(p, F));
    RUN(5, { p5_ret_out(p, F); __syncthreads(); p5_attention(p, F); });
    RUN(7, { pg8::StaticOrder S; S.init(SEQ, DM, DM, F.ws + WS_WOUT, F.G, F.bid); pg8::EpiBf16ResMid E{(bf16_t*)(F.ws + WS_H1), p.x, DM, (const float*)(F.ws + WS_ATTO), (LAS float*)(F.lds + LDS_MISC + 4096)};
        pg8::gemm_phase<DM>(F.lds, (const char*)(F.ws + WS_MIXA), S, E); });
    RUN(8, p8_router(p, F));
    RUN(9, { const MoeTab T = moe_table(F, true); moe_gemm<DM, true>(p, F, T); });
    RUN(10, { const MoeTab T = moe_table(F, MK_TABLE_EVERY_PHASE); moe_gemm<DEXP, false>(p, F, T); });
    RUN(11, p11_final(p, F));
#undef RUN
#undef IN
#undef SEAM
}

extern "C" void kernel_launch(void* const* d_in, const int* in_sizes, int n_in, void* d_out, int out_size, void* d_ws, size_t ws_size, hipStream_t stream) {
    static int grid = 0;
    if (grid == 0) {
        if (n_in != 20 || out_size != SEQ * DM || ws_size < WS_END) { fprintf(stderr, "kernel_launch: unexpected shapes: n_in %d out %d ws %zu (need %zu)\n", n_in, out_size, ws_size, (size_t)WS_END); grid = -1; return; }
        int dev = 0, cus = 0, per_cu = 0;
        if (hipGetDevice(&dev) != hipSuccess || hipDeviceGetAttribute(&cus, hipDeviceAttributeMultiprocessorCount, dev) != hipSuccess) { grid = -1; return; }
        if (hipFuncSetAttribute((const void*)mk_fwd, hipFuncAttributeMaxDynamicSharedMemorySize, LDS_BYTES) != hipSuccess) { fprintf(stderr, "kernel_launch: hipFuncSetAttribute failed\n"); grid = -1; return; }
        if (hipOccupancyMaxActiveBlocksPerMultiprocessor(&per_cu, (const void*)mk_fwd, NTHREADS, LDS_BYTES) != hipSuccess || per_cu < 1) { fprintf(stderr, "kernel_launch: occupancy query says %d\n", per_cu); }
        (void)hipGetLastError();
        grid = cus;
    }
    if (grid < 0) return;
    (void)hipMemsetAsync((char*)d_ws + WS_CTL, 0, CTL_BYTES, stream);
    Params p{};
    p.x = (const float*)d_in[0]; p.meta = (const float*)d_in[1]; p.norm_mix_g = (const float*)d_in[2]; p.w_in = (const float*)d_in[3]; p.lf = (const float*)d_in[4]; p.lb = (const float*)d_in[5];
    p.ret_norm_g = (const float*)d_in[6]; p.gq = (const float*)d_in[7]; p.gk = (const float*)d_in[8]; p.attn_out_g = (const float*)d_in[9]; p.w_out = (const float*)d_in[10]; p.norm_ffn_g = (const float*)d_in[11];
    p.wg = (const float*)d_in[12]; p.bg = (const float*)d_in[13]; p.we = (const float*)d_in[14]; p.be = (const float*)d_in[15]; p.w_gate = (const float*)d_in[16]; p.w_up = (const float*)d_in[17]; p.w_down = (const float*)d_in[18];
    p.norm_final_g = (const float*)d_in[19]; p.out = (float*)d_out; p.ws = (unsigned char*)d_ws;
#if MK_N_LAUNCHES == 1
    p.ph_lo = 0; p.ph_hi = N_PHASES;
    hipLaunchKernelGGL(mk_fwd, dim3(grid), dim3(NTHREADS), LDS_BYTES, stream, p);
#else
    for (int k = 0; k < N_PHASES; ++k) { p.ph_lo = k; p.ph_hi = k + 1; hipLaunchKernelGGL(mk_fwd, dim3(grid), dim3(NTHREADS), LDS_BYTES, stream, p); }
#endif
    const hipError_t le = hipPeekAtLastError();
    if (le != hipSuccess) fprintf(stderr, "kernel_launch: launch failed: %s\n", hipGetErrorName(le));
}
```
